# Optimizing an MI355X kernel written in HIP

```python
import math
import jax, jax.numpy as jnp
from jax import lax
import numpy as np

D_MODEL = 1024
BATCH = 8
SEQ = 8192
DEPTH = 1
DEC_BATCH = 16
DEC_SEQ = 32
PAST_LEN = 1024

CHUNK = 64
MIX_WIDTH = D_MODEL
GDN_HEADS = 4
GDN_DK = MIX_WIDTH // 2 // GDN_HEADS
GDN_DV = MIX_WIDTH // 2 // GDN_HEADS
GDN_KEY_DIM = GDN_HEADS * GDN_DK
GDN_VAL_DIM = GDN_HEADS * GDN_DV
GDN_CONV_DIM = 2 * GDN_KEY_DIM + GDN_VAL_DIM
CONV_W = 4
DIFF_HEADS = 4
DIFF_DV = MIX_WIDTH // 2 // DIFF_HEADS
DIFF_DQK = DIFF_DV // 2
ROT_DIM = DIFF_DQK // 4
ROPE_THETA = 500000.0
Q_BLOCK = 128
N_MEM = 256
MEM_HEADS = 4
MEM_HD = 128
D_FF = 4 * D_MODEL
NORM_EPS = 1e-6
_IN_SIZES = (GDN_CONV_DIM, GDN_VAL_DIM, GDN_HEADS, GDN_HEADS,
             DIFF_HEADS * 2 * DIFF_DQK, DIFF_HEADS * 2 * DIFF_DQK, DIFF_HEADS * DIFF_DV)
D_IN = sum(_IN_SIZES)
IN_SPLITS = tuple(int(s) for s in np.cumsum(_IN_SIZES)[:-1])

kernel_name = 'hybrid_gdn_diffattn_stream_step'


def rms_norm(x, g):
    xf = x.astype(jnp.float32)
    y = xf * lax.rsqrt(jnp.mean(xf * xf, axis=-1, keepdims=True) + NORM_EPS)
    return (y * g.astype(jnp.float32)).astype(x.dtype)


def l2_normalize(x):
    xf = x.astype(jnp.float32)
    return xf * lax.rsqrt(jnp.sum(xf * xf, axis=-1, keepdims=True) + NORM_EPS)


def apply_partial_rope(x, pos):
    inv = ROPE_THETA ** (-jnp.arange(0, ROT_DIM, 2, dtype=jnp.float32) / ROT_DIM)
    ang = pos.astype(jnp.float32)[:, None] * inv[None, :]
    cos = jnp.cos(ang)[None, :, None, None, :]
    sin = jnp.sin(ang)[None, :, None, None, :]
    xr = x[..., :ROT_DIM].astype(jnp.float32)
    x1, x2 = xr[..., :ROT_DIM // 2], xr[..., ROT_DIM // 2:]
    rot = jnp.concatenate([x1 * cos - x2 * sin, x2 * cos + x1 * sin], axis=-1)
    return jnp.concatenate([rot.astype(x.dtype), x[..., ROT_DIM:]], axis=-1)


def causal_conv(x, prev, w):
    t = x.shape[1]
    xp = jnp.concatenate([prev.astype(x.dtype), x], axis=1)
    y = xp[:, 0:t] * w[0]
    for i in range(1, CONV_W):
        y = y + xp[:, i:i + t] * w[i]
    return y, xp[:, -(CONV_W - 1):]


def gated_delta_rule(q, k, v, g, beta, s0):
    b, t, h, _ = q.shape
    dv = v.shape[-1]
    c = min(t, CHUNK)
    n = t // c
    f32 = jnp.float32

    def blocks(a):
        return a.astype(f32).reshape((b, n, c) + a.shape[2:]).swapaxes(2, 3)

    qb, kb, vb, gb, bb = (blocks(a) for a in (q, k, v, g, beta))
    gc = jnp.cumsum(gb, axis=-1)
    idx = jnp.arange(c)
    tril = idx[:, None] >= idx[None, :]
    strict = idx[:, None] > idx[None, :]
    decay = jnp.exp(jnp.where(tril, gc[..., :, None] - gc[..., None, :], -jnp.inf))
    kbeta = kb * bb[..., None]
    m = jnp.where(strict, jnp.einsum('bnhid,bnhjd->bnhij', kbeta, kb) * decay, 0.0)
    eye = jnp.eye(c, dtype=f32)
    tinv = lax.linalg.triangular_solve(eye + m, jnp.broadcast_to(eye, m.shape), left_side=True, lower=True)
    u = tinv @ (vb * bb[..., None])
    w = tinv @ (kbeta * jnp.exp(gc)[..., None])
    aqk = jnp.einsum('bnhid,bnhjd->bnhij', qb, kb) * decay
    qg = qb * jnp.exp(gc)[..., None]
    kd = kb * jnp.exp(gc[..., -1:] - gc)[..., None]
    glast = jnp.exp(gc[..., -1])

    def step(s, xs):
        u_n, w_n, a_n, qg_n, kd_n, gl_n = xs
        v_new = u_n - jnp.einsum('bhck,bhkv->bhcv', w_n, s)
        o_n = jnp.einsum('bhck,bhkv->bhcv', qg_n, s) + jnp.einsum('bhij,bhjv->bhiv', a_n, v_new)
        s = s * gl_n[..., None, None] + jnp.einsum('bhck,bhcv->bhkv', kd_n, v_new)
        return s, o_n

    xs = tuple(jnp.moveaxis(a, 1, 0) for a in (u, w, aqk, qg, kd, glast))
    s_fin, o = lax.scan(step, s0.astype(f32), xs)
    o = jnp.moveaxis(o, 0, 1).swapaxes(2, 3).reshape(b, t, h, dv)
    return o, s_fin


def gdn_mixer(qkv, z, a, bgate, conv_prev, s0, conv_w, a_log, dt_bias, norm_g):
    b, t, _ = qkv.shape
    y, conv_new = causal_conv(qkv, conv_prev, conv_w)
    y = jax.nn.silu(y)
    q, k, v = jnp.split(y, [GDN_KEY_DIM, 2 * GDN_KEY_DIM], axis=-1)
    q = l2_normalize(q.reshape(b, t, GDN_HEADS, GDN_DK)) * (GDN_DK ** -0.5)
    k = l2_normalize(k.reshape(b, t, GDN_HEADS, GDN_DK))
    v = v.reshape(b, t, GDN_HEADS, GDN_DV)
    beta = jax.nn.sigmoid(bgate.astype(jnp.float32))
    g = -jnp.exp(a_log.astype(jnp.float32)) * jax.nn.softplus(a.astype(jnp.float32) + dt_bias.astype(jnp.float32))
    o, s_new = gated_delta_rule(q, k, v, g, beta, s0)
    o = rms_norm(o.astype(qkv.dtype), norm_g) * jax.nn.silu(z.reshape(b, t, GDN_HEADS, GDN_DV))
    return o.reshape(b, t, GDN_VAL_DIM), s_new, conv_new


def diff_attend(q, k, v, q_pos, k_pos, lam):
    s = jnp.einsum('bqhsd,bkhsd->bhsqk', q, k).astype(jnp.float32) * (DIFF_DQK ** -0.5)
    mask = (k_pos[None, :] // CHUNK) <= (q_pos[:, None] // CHUNK)
    s = jnp.where(mask, s, -jnp.inf)
    p = jax.nn.softmax(s, axis=-1)
    att = p[:, :, 0] - lam * p[:, :, 1]
    return jnp.einsum('bhqk,bkhd->bqhd', att.astype(v.dtype), v)


def diff_attention_blocked(q, k, v, pos, lam):
    b, t = q.shape[:2]
    nb = t // Q_BLOCK
    qb = q.reshape((b, nb, Q_BLOCK) + q.shape[2:]).swapaxes(0, 1)
    pb = pos.reshape(nb, Q_BLOCK)

    def one(args):
        q_blk, p_blk = args
        return diff_attend(q_blk, k, v, p_blk, pos, lam)

    o = lax.map(one, (qb, pb))
    return o.swapaxes(0, 1).reshape(b, t, DIFF_HEADS, DIFF_DV)


def cross_attend(h, mem_k, mem_v, w_mq, w_mo):
    b, t, _ = h.shape
    q = (h @ w_mq).reshape(b, t, MEM_HEADS, MEM_HD)
    s = jnp.einsum('bqhd,bkhd->bhqk', q, mem_k.astype(q.dtype)).astype(jnp.float32) * (MEM_HD ** -0.5)
    p = jax.nn.softmax(s, axis=-1)
    o = jnp.einsum('bhqk,bkhd->bqhd', p.astype(h.dtype), mem_v.astype(h.dtype))
    return o.reshape(b, t, MEM_HEADS * MEM_HD) @ w_mo


def encoder_layer(x, pos, conv_prev, s0, kv_prev, mem_k, mem_v, lw, layer_idx):
    (norm_mix_g, w_in, gdn_conv_w, gdn_a_log, gdn_dt_bias, gdn_norm_g, diff_lambda, diff_norm_g,
     w_out, norm_mem_g, w_mq, w_mo, norm_ffn_g, w_up, w_down) = lw
    b, t, _ = x.shape
    h = rms_norm(x, norm_mix_g)
    proj = h @ w_in
    qkv_g, z_g, a_g, b_g, q_d, k_d, v_d = jnp.split(proj, IN_SPLITS, axis=-1)
    if conv_prev is None:
        conv_prev = jnp.zeros((b, CONV_W - 1, GDN_CONV_DIM), proj.dtype)
    if s0 is None:
        s0 = jnp.zeros((b, GDN_HEADS, GDN_DK, GDN_DV), jnp.float32)
    o_gdn, s_new, conv_new = gdn_mixer(qkv_g, z_g, a_g, b_g, conv_prev, s0,
                                       gdn_conv_w, gdn_a_log, gdn_dt_bias, gdn_norm_g)
    q_d = apply_partial_rope(q_d.reshape(b, t, DIFF_HEADS, 2, DIFF_DQK), pos)
    k_d = apply_partial_rope(k_d.reshape(b, t, DIFF_HEADS, 2, DIFF_DQK), pos)
    v_d = v_d.reshape(b, t, DIFF_HEADS, DIFF_DV)
    lam_init = 0.8 - 0.6 * math.exp(-0.3 * layer_idx)
    lf = diff_lambda.astype(jnp.float32)
    lam = jnp.exp(jnp.sum(lf[0] * lf[1])) - jnp.exp(jnp.sum(lf[2] * lf[3])) + lam_init
    if kv_prev is None:
        o_diff = diff_attention_blocked(q_d, k_d, v_d, pos, lam)
    else:
        k_prev, v_prev = kv_prev
        p_len = k_prev.shape[1]
        k_all = jnp.concatenate([k_prev.reshape(b, p_len, DIFF_HEADS, 2, DIFF_DQK).astype(k_d.dtype), k_d], axis=1)
        v_all = jnp.concatenate([v_prev.astype(v_d.dtype), v_d], axis=1)
        o_diff = diff_attend(q_d, k_all, v_all, pos, jnp.arange(p_len + t), lam)
    o_diff = rms_norm(o_diff, diff_norm_g) * (1.0 - lam_init)
    mix = jnp.concatenate([o_gdn, o_diff.reshape(b, t, DIFF_HEADS * DIFF_DV)], axis=-1)
    x = x + mix @ w_out
    x = x + cross_attend(rms_norm(x, norm_mem_g), mem_k, mem_v, w_mq, w_mo)
    hf = rms_norm(x, norm_ffn_g)
    x = x + jnp.square(jax.nn.relu(hf @ w_up)) @ w_down
    return x, s_new, conv_new, k_d.reshape(b, t, DIFF_HEADS, 2 * DIFF_DQK), v_d


def setup_inputs(seed: int = 0) -> dict:
    key = jax.random.key(seed)
    ks = jax.random.split(key, 32)
    f32 = jnp.float32
    nrm = lambda k, shape, s: jax.random.normal(k, shape, f32) * s
    gain = lambda k, shape: 1.0 + 0.05 * jax.random.normal(k, shape, f32)
    dt = jnp.exp(jax.random.uniform(ks[16], (DEPTH, GDN_HEADS), f32, math.log(1e-3), math.log(1e-1)))
    return {
        'x_prompt': nrm(ks[0], (BATCH, SEQ, D_MODEL), 1.0),
        'x_sample': nrm(ks[1], (DEC_BATCH, DEC_SEQ, D_MODEL), 1.0),
        'mem_prompt': nrm(ks[2], (BATCH, N_MEM, D_MODEL), 1.0),
        'cache_diff_k': nrm(ks[3], (DEPTH, DEC_BATCH, PAST_LEN, DIFF_HEADS, 2 * DIFF_DQK), 1.0),
        'cache_diff_v': nrm(ks[4], (DEPTH, DEC_BATCH, PAST_LEN, DIFF_HEADS, DIFF_DV), 1.0),
        'cache_mem_k': nrm(ks[5], (DEPTH, DEC_BATCH, N_MEM, MEM_HEADS, MEM_HD), 1.0),
        'cache_mem_v': nrm(ks[6], (DEPTH, DEC_BATCH, N_MEM, MEM_HEADS, MEM_HD), 1.0),
        'state_gdn': nrm(ks[7], (DEPTH, DEC_BATCH, GDN_HEADS, GDN_DK, GDN_DV), 0.1),
        'state_gdn_conv': nrm(ks[8], (DEPTH, DEC_BATCH, CONV_W - 1, GDN_CONV_DIM), 1.0),
        'norm_mix_g': gain(ks[9], (DEPTH, D_MODEL)),
        'w_in': nrm(ks[10], (DEPTH, D_MODEL, D_IN), D_MODEL ** -0.5),
        'gdn_conv_w': nrm(ks[11], (DEPTH, CONV_W, GDN_CONV_DIM), CONV_W ** -0.5),
        'gdn_a_log': jnp.log(jax.random.uniform(ks[12], (DEPTH, GDN_HEADS), f32, 1.0, 16.0)),
        'gdn_dt_bias': jnp.log(jnp.expm1(dt)),
        'gdn_norm_g': gain(ks[13], (DEPTH, GDN_DV)),
        'diff_lambda': nrm(ks[14], (DEPTH, 4, DIFF_DQK), 0.1),
        'diff_norm_g': gain(ks[15], (DEPTH, DIFF_DV)),
        'w_out': nrm(ks[17], (DEPTH, MIX_WIDTH, D_MODEL), MIX_WIDTH ** -0.5),
        'norm_mem_g': gain(ks[18], (DEPTH, D_MODEL)),
        'mem_norm_g': gain(ks[19], (DEPTH, D_MODEL)),
        'w_mq': nrm(ks[20], (DEPTH, D_MODEL, MEM_HEADS * MEM_HD), D_MODEL ** -0.5),
        'w_mkv': nrm(ks[21], (DEPTH, D_MODEL, 2 * MEM_HEADS * MEM_HD), D_MODEL ** -0.5),
        'w_mo': nrm(ks[22], (DEPTH, MEM_HEADS * MEM_HD, D_MODEL), (MEM_HEADS * MEM_HD) ** -0.5),
        'norm_ffn_g': gain(ks[23], (DEPTH, D_MODEL)),
        'w_up': nrm(ks[24], (DEPTH, D_MODEL, D_FF), D_MODEL ** -0.5),
        'w_down': nrm(ks[25], (DEPTH, D_FF, D_MODEL), 0.5 * D_FF ** -0.5),
        'final_norm_g': gain(ks[26], (D_MODEL,)),
    }


def reference(x_prompt, x_sample, mem_prompt, cache_diff_k, cache_diff_v, cache_mem_k, cache_mem_v,
              state_gdn, state_gdn_conv, norm_mix_g, w_in, gdn_conv_w, gdn_a_log, gdn_dt_bias, gdn_norm_g,
              diff_lambda, diff_norm_g, w_out, norm_mem_g, mem_norm_g, w_mq, w_mkv, w_mo,
              norm_ffn_g, w_up, w_down, final_norm_g):
    bp, tp, _ = x_prompt.shape
    ts = x_sample.shape[1]
    p_len = cache_diff_k.shape[2]
    pos_p = jnp.arange(tp)
    pos_s = p_len + jnp.arange(ts)
    hp, hs = x_prompt, x_sample
    p_s, p_c, p_k, p_v, p_mk, p_mv = [], [], [], [], [], []
    s_s, s_c, s_k, s_v = [], [], [], []
    for l in range(DEPTH):
        lw = (norm_mix_g[l], w_in[l], gdn_conv_w[l], gdn_a_log[l], gdn_dt_bias[l], gdn_norm_g[l],
              diff_lambda[l], diff_norm_g[l], w_out[l], norm_mem_g[l], w_mq[l], w_mo[l],
              norm_ffn_g[l], w_up[l], w_down[l])
        mh = rms_norm(mem_prompt, mem_norm_g[l])
        mk, mv = jnp.split(mh @ w_mkv[l], 2, axis=-1)
        mk = mk.reshape(bp, -1, MEM_HEADS, MEM_HD)
        mv = mv.reshape(bp, -1, MEM_HEADS, MEM_HD)
        hp, sp, cp, kp, vp = encoder_layer(hp, pos_p, None, None, None, mk, mv, lw, l)
        hs, ss, cs, ks_, vs = encoder_layer(hs, pos_s, state_gdn_conv[l], state_gdn[l],
                                            (cache_diff_k[l], cache_diff_v[l]),
                                            cache_mem_k[l], cache_mem_v[l], lw, l)
        p_s.append(sp); p_c.append(cp); p_k.append(kp); p_v.append(vp); p_mk.append(mk); p_mv.append(mv)
        s_s.append(ss); s_c.append(cs); s_k.append(ks_); s_v.append(vs)
    y_prompt = rms_norm(hp, final_norm_g)
    y_sample = rms_norm(hs, final_norm_g)
    return (y_prompt, y_sample,
            jnp.stack(p_s), jnp.stack(p_c), jnp.stack(p_k), jnp.stack(p_v), jnp.stack(p_mk), jnp.stack(p_mv),
            jnp.stack(s_s), jnp.stack(s_c), jnp.stack(s_k), jnp.stack(s_v))
```

```cpp
#include <hip/hip_runtime.h>
#include <hip/hip_cooperative_groups.h>
#include <cstdio>
#include <cstdint>
namespace cg = cooperative_groups;

#ifndef MK_SINGLE
#define MK_SINGLE 1
#endif

constexpr int DM = 1024, TP = 8192, NBP = 8, MP = NBP * TP, NBS = 16, TS = 32, MS = NBS * TS, MT = MP + MS;
constexpr int PAST = 1024, SKV = PAST + TS, NMEM = 256;
constexpr int DIN = 3592, NIN = 3584, DFF = 4096;
constexpr int NCHUNK_P = NBP * (TP / 64);
constexpr int NUNIT_CH = NCHUNK_P * 4 + NBS * 4;
constexpr int KROWS = MP + NBS * SKV;
constexpr float EPS = 1e-6f;
constexpr float QSCALE_D = 0.18033688011112042f;
constexpr float QSCALE_M = 0.12751743082459868f;

constexpr size_t O_Y = 0;
constexpr size_t O_PSTATE = (size_t)MT * DM;
constexpr size_t O_PCONV = O_PSTATE + (size_t)NBP * 4 * 128 * 128;
constexpr size_t O_PK = O_PCONV + (size_t)NBP * 3 * 1536;
constexpr size_t O_PV = O_PK + (size_t)MP * 512;
constexpr size_t O_PMK = O_PV + (size_t)MP * 512;
constexpr size_t O_PMV = O_PMK + (size_t)NBP * NMEM * 512;
constexpr size_t O_SSTATE = O_PMV + (size_t)NBP * NMEM * 512;
constexpr size_t O_SCONV = O_SSTATE + (size_t)NBS * 4 * 128 * 128;
constexpr size_t O_SK = O_SCONV + (size_t)NBS * 3 * 1536;
constexpr size_t O_SV = O_SK + (size_t)MS * 512;
constexpr size_t O_END = O_SV + (size_t)MS * 512;
static_assert(O_END == 139046912, "d_out size");

constexpr size_t MiB = 1u << 20;
constexpr size_t WS_WIN = 0;
constexpr size_t WS_WOUT = 7 * MiB;
constexpr size_t WS_WMQ = 9 * MiB;
constexpr size_t WS_WMKV = 10 * MiB;
constexpr size_t WS_WMO = 12 * MiB;
constexpr size_t WS_WUP = 13 * MiB;
constexpr size_t WS_WDN = 21 * MiB;
constexpr size_t WS_MH = 29 * MiB;
constexpr size_t WS_KM = 33 * MiB;
constexpr size_t WS_VM = 39 * MiB;
constexpr size_t WS_ROPE = 45 * MiB;
constexpr size_t WS_GG = 46 * MiB;
constexpr size_t WS_GB = 48 * MiB;
constexpr size_t WS_SSQ = 50 * MiB;
constexpr size_t WS_GL = 55 * MiB;
constexpr size_t WS_CTR = 55 * MiB + 65536;
constexpr size_t WS_BAR = 55 * MiB + 131072;
constexpr size_t WS_R1 = 56 * MiB;
constexpr size_t WS_R2 = 185 * MiB;
constexpr size_t WS_Z = WS_R2;
constexpr size_t WS_QD = WS_R2 + (size_t)MT * 512 * 2;
constexpr size_t WS_R3 = 314 * MiB;
constexpr size_t WS_QKVPRE = WS_R3;
constexpr size_t WS_KB = WS_QKVPRE + (size_t)MT * 1536 * 2;
constexpr size_t WS_VB = WS_KB + (size_t)KROWS * 512 * 2;
constexpr size_t CH_BYTES = 73728;
constexpr size_t WS_CH = WS_VB + (size_t)KROWS * 512 * 2;
constexpr size_t WS_END = WS_CH + (size_t)NUNIT_CH * CH_BYTES;
constexpr size_t WS_XBS = 962 * MiB, WS_QMS = 963 * MiB, WS_HS = 964 * MiB;
static_assert(WS_END <= WS_XBS && WS_HS + (size_t)MS * DFF * 2 <= 1024 * MiB, "ws map sample tail");
constexpr size_t WS_QM = 832 * MiB;
constexpr size_t WS_H = WS_R3;
static_assert(WS_QM >= WS_H + (size_t)MP * DFF * 2 && WS_QM + (size_t)MP * 512 * 2 <= WS_XBS, "ws map QM");
static_assert(WS_END <= 1024 * MiB, "ws map");
static_assert(WS_H + (size_t)MT * DFF * 2 <= 1024 * MiB, "ws map H");
static_assert(WS_R1 + (size_t)MT * DM * 2 <= WS_R2 && WS_R2 + (size_t)MT * DM * 2 <= WS_R3, "ws map R1/R2");

constexpr int LDS_BYTES = 147456;

#define LAS __attribute__((address_space(3)))
typedef unsigned short bf16_t;
typedef short bf16x8 __attribute__((ext_vector_type(8)));
typedef short s16x4 __attribute__((ext_vector_type(4)));
typedef float f32x4 __attribute__((ext_vector_type(4)));
typedef float f32x2 __attribute__((ext_vector_type(2)));
typedef float f32x16 __attribute__((ext_vector_type(16)));
typedef unsigned u32x4 __attribute__((ext_vector_type(4)));
typedef unsigned u32x2 __attribute__((ext_vector_type(2)));
typedef __bf16 bf16x2_t __attribute__((ext_vector_type(2)));

__device__ __forceinline__ unsigned pk2(float lo, float hi) { f32x2 v = {lo, hi}; bf16x2_t b = __builtin_convertvector(v, bf16x2_t); return __builtin_bit_cast(unsigned, b); }
__device__ __forceinline__ float bf_lo(unsigned u) { return __uint_as_float(u << 16); }
__device__ __forceinline__ float bf_hi(unsigned u) { return __uint_as_float(u & 0xffff0000u); }
__device__ __forceinline__ bf16_t f2bf(float f) { return (bf16_t)(pk2(f, 0.f) & 0xffffu); }
template <int M> __device__ __forceinline__ float swz_xor(float v) { static_assert(M > 0 && M < 32, "swizzle xor mask"); return __builtin_bit_cast(float, __builtin_amdgcn_ds_swizzle(__builtin_bit_cast(int, v), (M << 10) | 0x1F)); }
__device__ __forceinline__ float half_sum(float v) { const unsigned u = __builtin_bit_cast(unsigned, v); auto rr = __builtin_amdgcn_permlane32_swap(u, u, false, false); return __builtin_bit_cast(float, (unsigned)rr[0]) + __builtin_bit_cast(float, (unsigned)rr[1]); }
__device__ __forceinline__ float half_max(float v) { const unsigned u = __builtin_bit_cast(unsigned, v); auto rr = __builtin_amdgcn_permlane32_swap(u, u, false, false); return fmaxf(__builtin_bit_cast(float, (unsigned)rr[0]), __builtin_bit_cast(float, (unsigned)rr[1])); }
__device__ __forceinline__ float wave_sum(float v) {
    v += swz_xor<1>(v); v += swz_xor<2>(v); v += swz_xor<4>(v); v += swz_xor<8>(v); v += swz_xor<16>(v);
    return half_sum(v);
}
__device__ __forceinline__ int crow(int reg, int h) { return (reg & 3) + 8 * (reg >> 2) + 4 * h; }
#define MFMA32(a, b, c) __builtin_amdgcn_mfma_f32_32x32x16_bf16((a), (b), (c), 0, 0, 0)
__device__ __forceinline__ int fragpos(int row, int col, int C) {
    const int frag = (row >> 5) * (C >> 4) + (col >> 4), e = col & 15;
    return ((frag * 64 + (row & 31) + 32 * ((e >> 2) & 1)) << 3) + ((e >> 3) << 2) + (e & 3);
}
__device__ __forceinline__ bf16x8 pack8(const f32x16& x, int s8) {
    u32x4 p; p.x = pk2(x[s8], x[s8 + 1]); p.y = pk2(x[s8 + 2], x[s8 + 3]); p.z = pk2(x[s8 + 4], x[s8 + 5]); p.w = pk2(x[s8 + 6], x[s8 + 7]);
    return __builtin_bit_cast(bf16x8, p);
}

__device__ __forceinline__ s16x4 vtr(const LAS unsigned char* p) { typedef short v4i16_t __attribute__((ext_vector_type(4))); return __builtin_bit_cast(s16x4, __builtin_amdgcn_ds_read_tr16_b64_v4i16((LAS v4i16_t*)p)); }

struct Params {
    const float* in[27];
    float* out;
    unsigned char* ws;
    int ph_lo, ph_hi, sub, pad;
};
namespace pg8 {
#define PG8_LAS __attribute__((address_space(3)))
typedef unsigned short bf16_t;
typedef short bf16x8 __attribute__((ext_vector_type(8)));
typedef float f32x4 __attribute__((ext_vector_type(4)));
typedef unsigned u32x4 __attribute__((ext_vector_type(4)));
constexpr int BM = 256, BK = 64, HALF = 128, HTB = HALF * BK * 2  , STAGE_BYTES = 8 * HTB, NXCD = 8, WGM = 8;

__host__ __device__ __forceinline__ int lds_byte(int r, int c) { const int st = (r >> 4) * 2 + (c >> 5), rr = r & 15, cc = c & 31, ob = rr * 64 + cc * 2; return st * 1024 + (ob ^ (((ob >> 9) & 1) << 5)); }
__host__ __device__ __forceinline__ void stage_rc(int b, int& R, int& C) { const int st = b / 1024, sb = b % 1024, swz = sb ^ (((sb >> 9) & 1) << 5); R = (st >> 1) * 16 + swz / 64; C = (st & 1) * 32 + (swz % 64) / 2; }
__host__ __device__ __forceinline__ int perm32(int rho) { const int n = rho >> 4, i = rho & 15; return 8 * (i >> 2) + 4 * n + (i & 3); }

struct Unit { int pm, pn, ko; };
struct Gemm { const bf16_t* A; const bf16_t* Bt; int M, N, K, Kn; };

struct StaticOrder {
    int nM, nN, nwg, G, c;
    __host__ __device__ void init(int M, int N, int G_, int c_) { nM = M / BM; nN = N / BM; nwg = nM * nN; G = G_; c = c_; }
    __host__ __device__ bool next(int i, Unit& u) const {
        const long L = (long)i * G + c; if (L >= nwg) return false;
        int wgid = (int)L; { const int q = nwg / NXCD, r = nwg % NXCD, xcd = wgid % NXCD, off = wgid / NXCD; wgid = (xcd < r ? xcd * (q + 1) : r * (q + 1) + (xcd - r) * q) + off; }
        const int nig = WGM * nN, gid = wgid / nig, fm = gid * WGM, gsz = (nM - fm) < WGM ? (nM - fm) : WGM;
        u.pm = fm + ((wgid % nig) % gsz); u.pn = (wgid % nig) / gsz; u.ko = 0; return true;
    }
    __device__ __forceinline__ void a_ready(const Unit&) const {}
    __device__ __forceinline__ void done(const Unit&) const {}
};

__device__ __forceinline__ unsigned cvt_pk_bf16(float lo, float hi) { unsigned r; asm volatile("v_cvt_pk_bf16_f32 %0, %1, %2" : "=v"(r) : "v"(lo), "v"(hi)); return r; }
}
namespace pg8 {
template <class Epi, class Sched, bool ALIGN_EPI = false, bool SP2 = false>
__device__ __forceinline__ void gemm_phase(PG8_LAS unsigned char* lds, const Gemm g, const Sched& S, const Epi& E) {
    int tid = threadIdx.x; asm volatile("" : "+v"(tid));
    const int wid = __builtin_amdgcn_readfirstlane(tid >> 6), lane = tid & 63, wr = wid >> 2, wc = wid & 3, fr = lane & 15, fq = lane >> 4;
    const int K = g.K, nt = g.Kn / BK;
    unsigned voffA[2], voffB[2];
#pragma unroll
    for (int i = 0; i < 2; ++i) { int R, C; stage_rc(tid * 16 + i * 8192, R, C); const int Rb = Epi::PERM ? ((R & ~31) + perm32(R & 31)) : R;
        voffA[i] = (unsigned)(R * K + C) * 2u; voffB[i] = (unsigned)(Rb * K + C) * 2u; }
    const size_t kstep = (size_t)(BK * 2);
    const size_t hstep = (size_t)HALF * K * 2;
    const size_t tstep = 2 * hstep;
    const unsigned ldsw = (unsigned)wid * 1024u;
    const int aoff = lds_byte(wr * 64 + fr, fq * 8), boff = lds_byte(wc * 32 + fr, fq * 8);
#define PG8_SA(b, h) (((b) * 2 + (h)) * HTB)
#define PG8_SB(b, h) ((4 + (b) * 2 + (h)) * HTB)
#define PG8_STAGE(bufoff, gbase, voff) do { _Pragma("unroll") for (int _i = 0; _i < 2; ++_i) \
        __builtin_amdgcn_global_load_lds((const unsigned*)((const char*)(gbase) + (voff)[_i]), (PG8_LAS unsigned*)(lds + (bufoff) + ldsw + _i * 8192), 16, 0, 0); } while (0)
#define PG8_LDA(dst, b, h) do { _Pragma("unroll") for (int m = 0; m < 4; ++m) _Pragma("unroll") for (int k = 0; k < 2; ++k) dst[m][k] = *(const PG8_LAS bf16x8*)(lds + PG8_SA(b, h) + aoff + m * 2048 + k * 1024); } while (0)
#define PG8_LDB(dst, b, h) do { _Pragma("unroll") for (int n = 0; n < 2; ++n) _Pragma("unroll") for (int k = 0; k < 2; ++k) dst[n][k] = *(const PG8_LAS bf16x8*)(lds + PG8_SB(b, h) + boff + n * 2048 + k * 1024); } while (0)
#define PG8_MMA(ai, bj, At, Bt) do { __builtin_amdgcn_s_setprio(1); _Pragma("unroll") for (int m = 0; m < 4; ++m) _Pragma("unroll") for (int n = 0; n < 2; ++n) _Pragma("unroll") for (int k = 0; k < 2; ++k) \
        acc[ai][bj][m][n] = __builtin_amdgcn_mfma_f32_16x16x32_bf16(Bt[n][k], At[m][k], acc[ai][bj][m][n], 0, 0, 0); __builtin_amdgcn_s_setprio(0); } while (0)
#define PG8_WAIT_V(n) asm volatile("s_waitcnt vmcnt(" #n ")" ::: "memory")
#define PG8_WAIT_L(n) asm volatile("s_waitcnt lgkmcnt(" #n ")" ::: "memory")
#define PG8_BAR __builtin_amdgcn_s_barrier()
#define PG8_SCHED __builtin_amdgcn_sched_barrier(0)
    Unit cur, nxt; int ui = 0;
    if (!S.next(0, cur)) return;
    f32x4 acc[2][2][4][2];
#pragma unroll
    for (int a = 0; a < 2; ++a)
#pragma unroll
        for (int b = 0; b < 2; ++b)
#pragma unroll
            for (int m = 0; m < 4; ++m)
#pragma unroll
                for (int n = 0; n < 2; ++n) acc[a][b][m][n] = (f32x4){0.f, 0.f, 0.f, 0.f};
    bf16x8 At[4][2], B0[2][2], B1[2][2];
    const char* cA = (const char*)g.A + (size_t)cur.pm * tstep + (size_t)cur.ko * 2; const char* cB = (const char*)g.Bt + (size_t)cur.pn * tstep + (size_t)cur.ko * 2;
    S.a_ready(cur);
    if constexpr (SP2) {
        PG8_STAGE(PG8_SB(0, 0), cB, voffB); PG8_STAGE(PG8_SB(0, 1), cB + hstep, voffB); PG8_STAGE(PG8_SA(0, 0), cA, voffA); PG8_STAGE(PG8_SA(0, 1), cA + hstep, voffA);
        if (wr == 1) PG8_BAR;
        PG8_WAIT_V(2); PG8_BAR;
        PG8_STAGE(PG8_SB(1, 0), cB + kstep, voffB); PG8_STAGE(PG8_SA(1, 0), cA + kstep, voffA); PG8_STAGE(PG8_SB(1, 1), cB + hstep + kstep, voffB);
        PG8_WAIT_V(6); PG8_BAR;
    } else {
        PG8_STAGE(PG8_SB(0, 0), cB, voffB); PG8_STAGE(PG8_SA(0, 0), cA, voffA); PG8_STAGE(PG8_SB(0, 1), cB + hstep, voffB); PG8_STAGE(PG8_SA(0, 1), cA + hstep, voffA);
        if (wr == 1) PG8_BAR;
        PG8_WAIT_V(4); PG8_BAR;
        PG8_STAGE(PG8_SB(1, 0), cB + kstep, voffB); PG8_STAGE(PG8_SA(1, 0), cA + kstep, voffA); PG8_STAGE(PG8_SB(1, 1), cB + hstep + kstep, voffB);
        PG8_WAIT_V(6); PG8_BAR;
    }
    for (;;) {
        const bool has_next = S.next(ui + 1, nxt);
        const char* nA = has_next ? (const char*)g.A + (size_t)nxt.pm * tstep + (size_t)nxt.ko * 2 : cA; const char* nB = has_next ? (const char*)g.Bt + (size_t)nxt.pn * tstep + (size_t)nxt.ko * 2 : cB;
        for (int t = 0; t < nt; t += 2) {
            const bool last = (t == nt - 2);
            const char* a1 = cA + (size_t)(t + 1) * kstep;
            const char* a2 = last ? nA : cA + (size_t)(t + 2) * kstep; const char* b2 = last ? nB : cB + (size_t)(t + 2) * kstep;
            const char* a3 = a2 + kstep; const char* b3 = b2 + kstep;
            if (last && has_next) S.a_ready(nxt);
            if constexpr (SP2) {
            PG8_LDB(B0, 0, 0); PG8_LDB(B1, 0, 1); PG8_SCHED; PG8_LDA(At, 0, 0); PG8_STAGE(PG8_SA(1, 1), a1 + hstep, voffA);
            PG8_WAIT_V(8); PG8_WAIT_L(0); PG8_BAR; PG8_MMA(0, 0, At, B0); PG8_MMA(0, 1, At, B1); PG8_BAR; PG8_SCHED;
            PG8_LDA(At, 0, 1); PG8_STAGE(PG8_SB(0, 0), b2, voffB); PG8_STAGE(PG8_SB(0, 1), b2 + hstep, voffB); PG8_STAGE(PG8_SA(0, 0), a2, voffA);
            PG8_WAIT_V(8); PG8_WAIT_L(0); PG8_BAR; PG8_MMA(1, 0, At, B0); PG8_MMA(1, 1, At, B1); PG8_BAR; PG8_SCHED;
            PG8_LDB(B0, 1, 0); PG8_LDB(B1, 1, 1); PG8_SCHED; PG8_LDA(At, 1, 0); PG8_STAGE(PG8_SA(0, 1), a2 + hstep, voffA);
            PG8_WAIT_V(8); PG8_WAIT_L(0); PG8_BAR; PG8_MMA(0, 0, At, B0); PG8_MMA(0, 1, At, B1); PG8_BAR; PG8_SCHED;
            PG8_LDA(At, 1, 1); PG8_STAGE(PG8_SB(1, 0), b3, voffB); PG8_STAGE(PG8_SB(1, 1), b3 + hstep, voffB); PG8_STAGE(PG8_SA(1, 0), a3, voffA);
            PG8_WAIT_V(8); PG8_WAIT_L(0); PG8_BAR; PG8_MMA(1, 0, At, B0); PG8_MMA(1, 1, At, B1); PG8_BAR; PG8_SCHED;
            } else {
            PG8_LDB(B0, 0, 0); PG8_SCHED; PG8_LDA(At, 0, 0); PG8_STAGE(PG8_SA(1, 1), a1 + hstep, voffA);
            PG8_WAIT_L(8); PG8_BAR; PG8_WAIT_L(0); PG8_MMA(0, 0, At, B0); PG8_BAR; PG8_SCHED;
            PG8_LDB(B1, 0, 1); PG8_STAGE(PG8_SB(0, 0), b2, voffB);
            PG8_BAR; PG8_WAIT_L(0); PG8_MMA(0, 1, At, B1); PG8_BAR;
            PG8_LDA(At, 0, 1); PG8_STAGE(PG8_SA(0, 0), a2, voffA);
            PG8_BAR; PG8_WAIT_L(0); PG8_MMA(1, 0, At, B0); PG8_BAR; PG8_SCHED;
            PG8_STAGE(PG8_SB(0, 1), b2 + hstep, voffB);
            PG8_WAIT_V(6); PG8_BAR; PG8_MMA(1, 1, At, B1); PG8_BAR;
            PG8_LDB(B0, 1, 0); PG8_SCHED; PG8_LDA(At, 1, 0); PG8_STAGE(PG8_SA(0, 1), a2 + hstep, voffA);
            PG8_WAIT_L(8); PG8_BAR; PG8_WAIT_L(0); PG8_MMA(0, 0, At, B0); PG8_BAR; PG8_SCHED;
            PG8_LDB(B1, 1, 1); PG8_STAGE(PG8_SB(1, 0), b3, voffB);
            PG8_BAR; PG8_WAIT_L(0); PG8_MMA(0, 1, At, B1); PG8_BAR;
            PG8_LDA(At, 1, 1); PG8_STAGE(PG8_SA(1, 0), a3, voffA);
            PG8_BAR; PG8_WAIT_L(0); PG8_MMA(1, 0, At, B0); PG8_BAR; PG8_SCHED;
            PG8_STAGE(PG8_SB(1, 1), b3 + hstep, voffB);
            PG8_WAIT_V(6); PG8_BAR; PG8_MMA(1, 1, At, B1); PG8_BAR;
            }
        }
        if constexpr (ALIGN_EPI) { if (wr == 0) PG8_BAR; }
        if constexpr (!Epi::AFTER_DRAIN) { E(acc, cur, wr, wc, fr, fq); S.done(cur); }
        if (!has_next) break;
#pragma unroll
        for (int a = 0; a < 2; ++a)
#pragma unroll
            for (int b = 0; b < 2; ++b)
#pragma unroll
                for (int m = 0; m < 4; ++m)
#pragma unroll
                    for (int n = 0; n < 2; ++n) acc[a][b][m][n] = (f32x4){0.f, 0.f, 0.f, 0.f};
        cur = nxt; cA = nA; cB = nB; ++ui;
        if constexpr (ALIGN_EPI) { if (wr == 1) PG8_BAR; }
    }
    PG8_WAIT_V(0);
    if constexpr (!ALIGN_EPI) { if (wr == 0) PG8_BAR; }
    PG8_BAR;
    if constexpr (Epi::AFTER_DRAIN) { E.fused(acc, cur, wr, wc, fr, fq, lds, wid, lane); S.done(cur); }
#undef PG8_SA
#undef PG8_SB
#undef PG8_STAGE
#undef PG8_LDA
#undef PG8_LDB
#undef PG8_MMA
#undef PG8_WAIT_V
#undef PG8_WAIT_L
#undef PG8_BAR
#undef PG8_SCHED
}
}
namespace pg8 {
__device__ __forceinline__ u32x4 pack8f(const f32x4& a, const f32x4& b) { u32x4 w; w.x = ::pk2(a[0], a[1]); w.y = ::pk2(a[2], a[3]); w.z = ::pk2(b[0], b[1]); w.w = ::pk2(b[2], b[3]); return w; }

struct EpiIn {
    static constexpr bool PERM = true, AFTER_DRAIN = false;
    bf16_t *qkvpre, *z, *qd, *kb, *vb; float* out; const float* rope;
#define EPI_ROWS(ai, m) const int row = u.pm * BM + (ai) * HALF + wr * 64 + (m) * 16 + fr; const bool smp = row >= MP; const int rs = row - MP; \
        const int t = smp ? (rs & 31) : (row & (TP - 1)); const int sq = smp ? (rs >> 5) : (row >> 13);
    __device__ __forceinline__ void operator()(const f32x4 (&acc)[2][2][4][2], const Unit& u, int wr, int wc, int fr, int fq) const {
        const int pn = u.pn, cl = wc * 32 + 8 * fq;
        if (pn < 6) {
#pragma unroll
            for (int ai = 0; ai < 2; ++ai)
#pragma unroll
                for (int m = 0; m < 4; ++m) { EPI_ROWS(ai, m)
                    const int tl = smp ? t - (TS - 3) : t - (TP - 3);
#pragma unroll
                    for (int bj = 0; bj < 2; ++bj) { const int c = pn * BM + bj * HALF + cl; const f32x4 v0 = acc[ai][bj][m][0], v1 = acc[ai][bj][m][1];
                        *(u32x4*)(qkvpre + (size_t)row * 1536 + c) = pack8f(v0, v1);
                        if (tl >= 0) { float* o = out + (smp ? O_SCONV : O_PCONV) + (size_t)(sq * 3 + tl) * 1536 + c; *(f32x4*)o = v0; *(f32x4*)(o + 4) = v1; } }
                    asm volatile("" ::: "memory"); }
        } else if (pn < 8) {
#pragma unroll
            for (int ai = 0; ai < 2; ++ai)
#pragma unroll
                for (int m = 0; m < 4; ++m) { const int row = u.pm * BM + ai * HALF + wr * 64 + m * 16 + fr;
#pragma unroll
                    for (int bj = 0; bj < 2; ++bj) { const int c = (pn - 6) * BM + bj * HALF + cl; *(u32x4*)(z + (size_t)row * 512 + c) = pack8f(acc[ai][bj][m][0], acc[ai][bj][m][1]); }
                    asm volatile("" ::: "memory"); }
        } else if (pn < 12) {
            const bool isq = pn < 10;
#pragma unroll
            for (int ai = 0; ai < 2; ++ai)
#pragma unroll
                for (int m = 0; m < 4; ++m) { EPI_ROWS(ai, m)
                    const int pos = smp ? PAST + t : t;
                    const float* rp = rope + (size_t)pos * 16;
                    const size_t kr = smp ? (size_t)MP + (size_t)sq * SKV + PAST + t : (size_t)row;
#pragma unroll
                    for (int bj = 0; bj < 2; ++bj) { const int cc = (pn & 1) * BM + bj * HALF + cl; f32x4 v0 = acc[ai][bj][m][0], v1 = acc[ai][bj][m][1];
                        if ((wc & 1) == 0) {
                            f32x4 p0, p1;
#pragma unroll
                            for (int e = 0; e < 4; ++e) { p0[e] = ::swz_xor<16>(v0[e]); p1[e] = ::swz_xor<16>(v1[e]); }
                            if (fq < 2) {
                                const f32x4 c0 = *(const f32x4*)(rp), c1 = *(const f32x4*)(rp + 4), s0 = *(const f32x4*)(rp + 8), s1 = *(const f32x4*)(rp + 12);
                                const float sg = fq == 0 ? -1.f : 1.f;
                                v0 = v0 * c0 + (p0 * s0) * sg; v1 = v1 * c1 + (p1 * s1) * sg;
                            }
                        }
                        if (isq) { *(u32x4*)(qd + (size_t)row * 512 + cc) = pack8f(v0 * QSCALE_D, v1 * QSCALE_D); }
                        else { float* o = out + (smp ? O_SK + (size_t)rs * 512 : O_PK + (size_t)row * 512) + cc; *(f32x4*)o = v0; *(f32x4*)(o + 4) = v1;
                               *(u32x4*)(kb + kr * 512 + cc) = pack8f(v0, v1); } }
                    asm volatile("" ::: "memory"); }
        } else {
#pragma unroll
            for (int ai = 0; ai < 2; ++ai)
#pragma unroll
                for (int m = 0; m < 4; ++m) { EPI_ROWS(ai, m)
                    const size_t kr = smp ? (size_t)MP + (size_t)sq * SKV + PAST + t : (size_t)row;
#pragma unroll
                    for (int bj = 0; bj < 2; ++bj) { const int cc = (pn & 1) * BM + bj * HALF + cl; const f32x4 v0 = acc[ai][bj][m][0], v1 = acc[ai][bj][m][1];
                        float* o = out + (smp ? O_SV + (size_t)rs * 512 : O_PV + (size_t)row * 512) + cc; *(f32x4*)o = v0; *(f32x4*)(o + 4) = v1;
                        *(u32x4*)(vb + kr * 512 + cc) = pack8f(v0, v1); }
                    asm volatile("" ::: "memory"); }
        }
    }
#undef EPI_ROWS
};
struct EpiMem {
    static constexpr bool PERM = true, AFTER_DRAIN = false;
    bf16_t *km, *vm; float* out;
    __device__ __forceinline__ void operator()(const f32x4 (&acc)[2][2][4][2], const Unit& u, int wr, int wc, int fr, int fq) const {
        const int pn = u.pn, cl = wc * 32 + 8 * fq;
#pragma unroll
        for (int ai = 0; ai < 2; ++ai)
#pragma unroll
            for (int m = 0; m < 4; ++m) {
                const int row = u.pm * BM + ai * HALF + wr * 64 + m * 16 + fr;
#pragma unroll
                for (int bj = 0; bj < 2; ++bj) {
                    const int c = pn * BM + bj * HALF + cl; const int cc = c & 511;
                    const f32x4 v0 = acc[ai][bj][m][0], v1 = acc[ai][bj][m][1];
                    float* o = out + (pn < 2 ? O_PMK : O_PMV) + (size_t)row * 512 + cc; *(f32x4*)o = v0; *(f32x4*)(o + 4) = v1;
                    *(u32x4*)((pn < 2 ? km : vm) + (size_t)row * 512 + cc) = pack8f(v0, v1);
                }
            }
    }
};
struct EpiRes {
    static constexpr bool PERM = true, AFTER_DRAIN = false;
    const float *resid_p, *resid_s; float* y; bf16_t* xb; float* ssq;
    __device__ __forceinline__ void operator()(const f32x4 (&acc)[2][2][4][2], const Unit& u, int wr, int wc, int fr, int fq) const {
        const int pn = u.pn, cl = wc * 32 + 8 * fq;
#pragma unroll
        for (int ai = 0; ai < 2; ++ai)
#pragma unroll
            for (int m = 0; m < 4; ++m) {
                const int row = u.pm * BM + ai * HALF + wr * 64 + m * 16 + fr;
                const float* rp = row < MP ? resid_p + (size_t)row * DM : resid_s + (size_t)(row - MP) * DM;
                float ss = 0.f;
#pragma unroll
                for (int bj = 0; bj < 2; ++bj) {
                    const int c = pn * BM + bj * HALF + cl;
                    const f32x4 v0 = acc[ai][bj][m][0] + *(const f32x4*)(rp + c), v1 = acc[ai][bj][m][1] + *(const f32x4*)(rp + c + 4);
                    *(f32x4*)(y + (size_t)row * DM + c) = v0; *(f32x4*)(y + (size_t)row * DM + c + 4) = v1;
                    if (xb) *(u32x4*)(xb + (size_t)row * DM + c) = pack8f(v0, v1);
                    ss += (v0[0] * v0[0] + v0[1] * v0[1]) + (v0[2] * v0[2] + v0[3] * v0[3]) + (v1[0] * v1[0] + v1[1] * v1[1]) + (v1[2] * v1[2] + v1[3] * v1[3]);
                }
                ss += ::swz_xor<16>(ss); ss = ::half_sum(ss);
                if (ssq && fq == 0) ssq[(size_t)row * 16 + pn * 4 + wc] = ss;
            }
    }
};
template <int ACT> struct EpiScale {
    static constexpr bool PERM = true, AFTER_DRAIN = false;
    bf16_t* O; int ldc; const float* ssq; float scale;
    __device__ __forceinline__ void operator()(const f32x4 (&acc)[2][2][4][2], const Unit& u, int wr, int wc, int fr, int fq) const {
        const int pn = u.pn, cl = wc * 32 + 8 * fq;
#pragma unroll
        for (int ai = 0; ai < 2; ++ai)
#pragma unroll
            for (int m = 0; m < 4; ++m) {
                const int row = u.pm * BM + ai * HALF + wr * 64 + m * 16 + fr;
                const f32x4* sp = (const f32x4*)(ssq + (size_t)row * 16);
                const f32x4 a = sp[0] + sp[1] + sp[2] + sp[3];
                const float rstd = __builtin_amdgcn_rsqf(((a[0] + a[1]) + (a[2] + a[3])) * (1.0f / DM) + EPS) * scale;
#pragma unroll
                for (int bj = 0; bj < 2; ++bj) {
                    const int c = pn * BM + bj * HALF + cl;
                    f32x4 v0 = acc[ai][bj][m][0] * rstd, v1 = acc[ai][bj][m][1] * rstd;
                    if (ACT == 1) {
#pragma unroll
                        for (int e = 0; e < 4; ++e) { const float a0 = fmaxf(v0[e], 0.f), a1 = fmaxf(v1[e], 0.f); v0[e] = a0 * a0; v1[e] = a1 * a1; }
                    }
                    *(u32x4*)(O + (size_t)row * ldc + c) = pack8f(v0, v1);
                }
            }
    }
};
struct EpiAtomic {
    static constexpr bool PERM = true, AFTER_DRAIN = false;
    float* y;
    __device__ __forceinline__ void operator()(const f32x4 (&acc)[2][2][4][2], const Unit& u, int wr, int wc, int fr, int fq) const {
        const int pn = u.pn, cl = wc * 32 + 8 * fq;
#pragma unroll
        for (int ai = 0; ai < 2; ++ai)
#pragma unroll
            for (int m = 0; m < 4; ++m) {
                const int row = u.pm * BM + ai * HALF + wr * 64 + m * 16 + fr;
#pragma unroll
                for (int bj = 0; bj < 2; ++bj) {
                    float* p = y + (size_t)row * DM + pn * BM + bj * HALF + cl;
#pragma unroll
                    for (int e = 0; e < 4; ++e) { unsafeAtomicAdd(p + e, acc[ai][bj][m][0][e]); unsafeAtomicAdd(p + 4 + e, acc[ai][bj][m][1][e]); }
                }
            }
    }
};
struct SplitKOrder {
    int pm0, nN, nks, klen, ntot, G, c;
    __device__ void init(int pm0_, int npm, int nN_, int nks_, int klen_, int G_, int c_) { pm0 = pm0_; nN = nN_; nks = nks_; klen = klen_; ntot = npm * nN_ * nks_; G = G_; c = c_; }
    __device__ bool next(int i, Unit& u) const { const int L = i * G + c; if (L >= ntot) return false; const int kc = L % nks, t = L / nks; u.pn = t % nN; u.pm = pm0 + t / nN; u.ko = kc * klen; return true; }
    __device__ __forceinline__ void a_ready(const Unit&) const {}
    __device__ __forceinline__ void done(const Unit&) const {}
};
struct TeamOrder {
    int pm0, nN, ntot, G, c;
    __device__ void init(int pm0_, int npm, int nN_, int G_, int c_) { pm0 = pm0_; nN = nN_; ntot = npm * nN_; G = G_; c = c_; }
    __device__ bool next(int i, Unit& u) const { const int L = i * G + c; if (L >= ntot) return false; u.pn = L % nN; u.pm = pm0 + L / nN; u.ko = 0; return true; }
    __device__ __forceinline__ void a_ready(const Unit&) const {}
    __device__ __forceinline__ void done(const Unit&) const {}
};
struct RowOrder {
    int pm, nN;
    __device__ bool next(int i, Unit& u) const { if (i >= nN) return false; int p = pm; asm volatile("" : "+s"(p)); u.pm = p; u.pn = i; u.ko = 0; return true; }
    __device__ __forceinline__ void a_ready(const Unit&) const {}
    __device__ __forceinline__ void done(const Unit&) const {}
};
struct OneUnit {
    int pm, pn;
    __device__ bool next(int i, Unit& u) const { if (i) return false; u.pm = pm; u.pn = pn; u.ko = 0; return true; }
    __device__ __forceinline__ void a_ready(const Unit&) const {}
    __device__ __forceinline__ void done(const Unit&) const {}
};
}
__device__ __forceinline__ void p0_tr_item(const float* __restrict__ W, int ldw, int K, int c0, int nblk, bf16_t* __restrict__ WT, int row0, const float* __restrict__ gk, LAS float* scr, int item, int lane) {
    const int kb = item / nblk, nb = item % nblk, k0 = 64 * kb, n0 = 32 * nb;
#pragma unroll 8
    for (int i = 0; i < 32; ++i) { const int kk = 2 * i + (lane >> 5); float v = W[(size_t)(k0 + kk) * ldw + c0 + n0 + (lane & 31)]; if (gk) v *= gk[k0 + kk]; scr[kk * 33 + (lane & 31)] = v; }
    asm volatile("s_waitcnt lgkmcnt(0)" ::: "memory");
    const int c = lane & 7;
#pragma unroll
    for (int j = 0; j < 4; ++j) { const int n = (lane >> 3) + 8 * j; const LAS float* s = scr + (8 * c) * 33 + n;
        u32x4 o; o.x = pk2(s[0 * 33], s[1 * 33]); o.y = pk2(s[2 * 33], s[3 * 33]); o.z = pk2(s[4 * 33], s[5 * 33]); o.w = pk2(s[6 * 33], s[7 * 33]);
        *(u32x4*)(WT + (size_t)(row0 + n0 + n) * K + k0 + 8 * c) = o; }
    asm volatile("s_waitcnt lgkmcnt(0)" ::: "memory");
}
__device__ __forceinline__ void p0_prologue(const Params& P, LAS unsigned char* lds) {
    const int tid = threadIdx.x, lane = tid & 63, wave = __builtin_amdgcn_readfirstlane(tid >> 6);
    const int gw = blockIdx.x * 8 + wave, NGW = gridDim.x * 8;
    unsigned char* ws = P.ws;
    if (blockIdx.x == 0 && tid < 256) ((unsigned*)(ws + WS_CTR))[tid] = 0u;
    LAS float* wab = (LAS float*)lds;
    const float* w_in = P.in[10];
    for (int i = tid; i < 8192; i += 512) { const int k = i >> 3, c = i & 7; wab[c * 1024 + k] = w_in[(size_t)k * DIN + 2048 + c]; }
    __syncthreads();
    LAS float* scr = (LAS float*)(lds + 32768 + wave * 8448);
    {
        constexpr int I0 = 16 * 64, I1 = 16 * 48, I2 = 16 * 32, I3 = 16 * 16, I4 = 16 * 32, I5 = 8 * 32, I6 = 16 * 128, I7 = 64 * 32;
        constexpr int NIT = I0 + I1 + I2 + I3 + I4 + I5 + I6 + I7;
        for (int it = gw; it < NIT; it += NGW) {
            int r = it;
            if (r < I0) { p0_tr_item(w_in, DIN, 1024, 0, 64, (bf16_t*)(ws + WS_WIN), 0, nullptr, scr, r, lane); continue; } r -= I0;
            if (r < I1) { p0_tr_item(w_in, DIN, 1024, 2056, 48, (bf16_t*)(ws + WS_WIN), 2048, nullptr, scr, r, lane); continue; } r -= I1;
            if (r < I2) { p0_tr_item(P.in[17], 1024, 1024, 0, 32, (bf16_t*)(ws + WS_WOUT), 0, nullptr, scr, r, lane); continue; } r -= I2;
            if (r < I3) { p0_tr_item(P.in[20], 512, 1024, 0, 16, (bf16_t*)(ws + WS_WMQ), 0, P.in[18], scr, r, lane); continue; } r -= I3;
            if (r < I4) { p0_tr_item(P.in[21], 1024, 1024, 0, 32, (bf16_t*)(ws + WS_WMKV), 0, nullptr, scr, r, lane); continue; } r -= I4;
            if (r < I5) { p0_tr_item(P.in[22], 1024, 512, 0, 32, (bf16_t*)(ws + WS_WMO), 0, nullptr, scr, r, lane); continue; } r -= I5;
            if (r < I6) { p0_tr_item(P.in[24], 4096, 1024, 0, 128, (bf16_t*)(ws + WS_WUP), 0, P.in[23], scr, r, lane); continue; } r -= I6;
            p0_tr_item(P.in[25], 1024, 4096, 0, 32, (bf16_t*)(ws + WS_WDN), 0, nullptr, scr, r, lane);
        }
    }
    {
        const float* gmix = P.in[9]; bf16_t* xn = (bf16_t*)(ws + WS_R1);
        float* GG = (float*)(ws + WS_GG); float* GB = (float*)(ws + WS_GB);
        f32x4 gn[4];
#pragma unroll
        for (int j = 0; j < 4; ++j) gn[j] = ((const f32x4*)gmix)[64 * j + lane];
        for (int m0 = gw; m0 < MT; m0 += 2 * NGW) {
            const int m1 = m0 + NGW; const bool has1 = m1 < MT; const int m1c = has1 ? m1 : m0;
            const float* xr0 = m0 < MP ? P.in[0] + (size_t)m0 * DM : P.in[1] + (size_t)(m0 - MP) * DM;
            const float* xr1 = m1c < MP ? P.in[0] + (size_t)m1c * DM : P.in[1] + (size_t)(m1c - MP) * DM;
            f32x4 v0[4], v1[4]; float s0 = 0.f, s1 = 0.f;
#pragma unroll
            for (int j = 0; j < 4; ++j) { v0[j] = ((const f32x4*)xr0)[64 * j + lane]; v1[j] = ((const f32x4*)xr1)[64 * j + lane]; }
#pragma unroll
            for (int j = 0; j < 4; ++j) { s0 += (v0[j][0] * v0[j][0] + v0[j][1] * v0[j][1]) + (v0[j][2] * v0[j][2] + v0[j][3] * v0[j][3]);
                                          s1 += (v1[j][0] * v1[j][0] + v1[j][1] * v1[j][1]) + (v1[j][2] * v1[j][2] + v1[j][3] * v1[j][3]); }
            s0 = wave_sum(s0); s1 = wave_sum(s1);
            const float r0 = 1.0f / sqrtf(s0 * (1.0f / DM) + EPS), r1 = 1.0f / sqrtf(s1 * (1.0f / DM) + EPS);
            float ga0[8], ga1[8];
#pragma unroll
            for (int c = 0; c < 8; ++c) { ga0[c] = 0.f; ga1[c] = 0.f; }
#pragma unroll
            for (int j = 0; j < 4; ++j) {
                v0[j] = v0[j] * r0 * gn[j]; v1[j] = v1[j] * r1 * gn[j];
                u32x2 o; o.x = pk2(v0[j][0], v0[j][1]); o.y = pk2(v0[j][2], v0[j][3]);
                *(u32x2*)(xn + (size_t)m0 * DM + 256 * j + 4 * lane) = o;
                if (has1) { o.x = pk2(v1[j][0], v1[j][1]); o.y = pk2(v1[j][2], v1[j][3]); *(u32x2*)(xn + (size_t)m1 * DM + 256 * j + 4 * lane) = o; }
#pragma unroll
                for (int c = 0; c < 8; ++c) { const f32x4 w = *(const LAS f32x4*)(wab + c * 1024 + 256 * j + 4 * lane);
                    ga0[c] += (v0[j][0] * w[0] + v0[j][1] * w[1]) + (v0[j][2] * w[2] + v0[j][3] * w[3]);
                    ga1[c] += (v1[j][0] * w[0] + v1[j][1] * w[1]) + (v1[j][2] * w[2] + v1[j][3] * w[3]); }
            }
#pragma unroll
            for (int c = 0; c < 8; ++c) { ga0[c] = wave_sum(ga0[c]); ga1[c] = wave_sum(ga1[c]); }
            if (lane < 8) {
                const int hl = lane & 3; const bool second = lane >= 4;
                float a = second ? ga1[0] : ga0[0], b = second ? ga1[4] : ga0[4];
                if (hl == 1) { a = second ? ga1[1] : ga0[1]; b = second ? ga1[5] : ga0[5]; } else if (hl == 2) { a = second ? ga1[2] : ga0[2]; b = second ? ga1[6] : ga0[6]; } else if (hl == 3) { a = second ? ga1[3] : ga0[3]; b = second ? ga1[7] : ga0[7]; }
                const int mm = second ? m1 : m0;
                if (!second || has1) {
                    const float xx = a + P.in[13][hl];
                    const float sp = xx > 20.f ? xx : log1pf(expf(xx));
                    GG[(size_t)mm * 4 + hl] = -expf(P.in[12][hl]) * sp;
                    GB[(size_t)mm * 4 + hl] = 1.0f / (1.0f + expf(-b));
                }
            }
        }
    }
    {
        const float* gm = P.in[19]; bf16_t* mh = (bf16_t*)(ws + WS_MH);
        for (int m = gw; m < NBP * NMEM; m += NGW) {
            const float* xrow = P.in[2] + (size_t)m * DM;
            f32x4 v[4]; float ss = 0.f;
#pragma unroll
            for (int j = 0; j < 4; ++j) { v[j] = ((const f32x4*)xrow)[64 * j + lane]; ss += (v[j][0] * v[j][0] + v[j][1] * v[j][1]) + (v[j][2] * v[j][2] + v[j][3] * v[j][3]); }
            const float rstd = 1.0f / sqrtf(wave_sum(ss) * (1.0f / DM) + EPS);
#pragma unroll
            for (int j = 0; j < 4; ++j) { const f32x4 g = ((const f32x4*)gm)[64 * j + lane]; const f32x4 o4 = v[j] * rstd * g;
                u32x2 o; o.x = pk2(o4[0], o4[1]); o.y = pk2(o4[2], o4[3]); *(u32x2*)(mh + (size_t)m * DM + 256 * j + 4 * lane) = o; }
        }
    }
    {
        constexpr int R0 = NBS * PAST, R1 = NBS * NMEM;
        for (int it = gw; it < 2 * R0 + 2 * R1; it += NGW) {
            int r = it; const float* src; bf16_t* dst;
            if (r < R0) { src = P.in[3] + (size_t)r * 512; dst = (bf16_t*)(ws + WS_KB) + ((size_t)MP + (size_t)(r >> 10) * SKV + (r & 1023)) * 512; }
            else if (r < 2 * R0) { r -= R0; src = P.in[4] + (size_t)r * 512; dst = (bf16_t*)(ws + WS_VB) + ((size_t)MP + (size_t)(r >> 10) * SKV + (r & 1023)) * 512; }
            else if (r < 2 * R0 + R1) { r -= 2 * R0; src = P.in[5] + (size_t)r * 512; dst = (bf16_t*)(ws + WS_KM) + (size_t)(NBP * NMEM + r) * 512; }
            else { r -= 2 * R0 + R1; src = P.in[6] + (size_t)r * 512; dst = (bf16_t*)(ws + WS_VM) + (size_t)(NBP * NMEM + r) * 512; }
            const f32x4 a = ((const f32x4*)src)[2 * lane], b = ((const f32x4*)src)[2 * lane + 1];
            u32x4 o; o.x = pk2(a[0], a[1]); o.y = pk2(a[2], a[3]); o.z = pk2(b[0], b[1]); o.w = pk2(b[2], b[3]);
            *(u32x4*)(dst + 8 * lane) = o;
        }
    }
    {
        float* rope = (float*)(ws + WS_ROPE);
        for (int e = blockIdx.x * 512 + tid; e < TP * 8; e += gridDim.x * 512) {
            const int pos = e >> 3, i = e & 7;
            const double inv = i == 0 ? 1.0 : i == 1 ? 0.19392274474868576 : i == 2 ? 0.03760603093086393 : i == 3 ? 0.007292664737217109 : i == 4 ? 0.001414213562373095 : i == 5 ? 0.0002742481756762073 : i == 6 ? 5.318295896944988e-05 : 1.031338537721246e-05;
            const double rev = (double)pos * inv * 0.15915494309189535;
            const float fr = (float)(rev - __builtin_rint(rev));
            rope[(size_t)pos * 16 + i] = __builtin_amdgcn_cosf(fr);
            rope[(size_t)pos * 16 + 8 + i] = __builtin_amdgcn_sinf(fr);
        }
    }
}
constexpr int G_K = 0, G_Q = 17408, G_X = 34816, G_KD = 71680, G_M = 92160, G_TB = 109568, G_GC = 118784, G_BE = 119040, G_AT = 119296, G_M21 = 121856, G_CW = 124416;
constexpr int G_XSTR = 576, G_KDSTR = 320;
__device__ __forceinline__ void chunk_unit(const Params& P, LAS unsigned char* lds, int U, int& cw_hd) {
    const int tid = threadIdx.x, lane = tid & 63, wave = __builtin_amdgcn_readfirstlane(tid >> 6), r = lane & 31, h = lane >> 5;
    unsigned char* ws = P.ws;
    const bool smp = U >= NCHUNK_P * 4; const int hd = U & 3, sc = U >> 2;
    const int sq = smp ? (sc - NCHUNK_P) : (sc >> 7), n = smp ? 0 : (sc & 127);
    const int seqbase = smp ? MP + sq * TS : sq * TP;
    const int nvalid = smp ? TS : 64;
    LAS bf16_t* sK = (LAS bf16_t*)(lds + G_K); LAS bf16_t* sQ = (LAS bf16_t*)(lds + G_Q);
    LAS unsigned char* sX = lds + G_X; LAS unsigned char* sKD = lds + G_KD;
    LAS float* sM = (LAS float*)(lds + G_M); LAS bf16_t* sTb = (LAS bf16_t*)(lds + G_TB);
    LAS float* sGC = (LAS float*)(lds + G_GC); LAS float* sBE = (LAS float*)(lds + G_BE);
    LAS bf16_t* sAt = (LAS bf16_t*)(lds + G_AT); LAS bf16_t* sM21 = (LAS bf16_t*)(lds + G_M21);
    LAS float* sCW = (LAS float*)(lds + G_CW);
    unsigned char* chb = ws + WS_CH + (size_t)U * CH_BYTES;
    bf16_t* gNW = (bf16_t*)chb; bf16_t* gQG = (bf16_t*)(chb + 16384); bf16_t* gKDT = (bf16_t*)(chb + 32768); bf16_t* gUT = (bf16_t*)(chb + 49152); bf16_t* gAQK = (bf16_t*)(chb + 65536);
    const int ci = tid >> 3, ccg = tid & 7, ctis = n * 64 + ci;
    u32x4 raw[2][4][2];
#define CH_LOADPART(part_, slot_) do { const bf16_t* qkvpre_ = (const bf16_t*)(ws + WS_QKVPRE); _Pragma("unroll") for (int j_ = 0; j_ < 4; ++j_) { const int tt_ = ctis - 3 + j_; \
        if (ci < nvalid && tt_ >= 0) { const u32x4* sp_ = (const u32x4*)(qkvpre_ + (size_t)(seqbase + tt_) * 1536 + (part_) * 512 + hd * 128 + 16 * ccg); raw[slot_][j_][0] = sp_[0]; raw[slot_][j_][1] = sp_[1]; } \
        else { raw[slot_][j_][0] = (u32x4){0u, 0u, 0u, 0u}; raw[slot_][j_][1] = (u32x4){0u, 0u, 0u, 0u}; } } } while (0)
    CH_LOADPART(0, 0); CH_LOADPART(1, 1);
    if (wave == 0) {
        const int i = lane; float g = 0.f, be = 0.f;
        if (i < nvalid) { const size_t row = (size_t)(seqbase + n * 64 + i); g = ((const float*)(ws + WS_GG))[row * 4 + hd]; be = ((const float*)(ws + WS_GB))[row * 4 + hd]; }
        sGC[i] = g; sBE[i] = be;
        { float acc = 0.f;
#pragma unroll 8
          for (int j = 0; j < 64; ++j) { const float gj = sGC[j]; acc += (j <= i) ? gj : 0.f; }
          g = acc; }
        sGC[i] = g;
        if (lane == 63) ((float*)(ws + WS_GL))[U] = __expf(g);
    }
    if (cw_hd != hd) {
        const float* cw = P.in[11];
        for (int e = tid; e < 4 * 384; e += 512) { const int j = e / 384, c = e % 384; sCW[e] = cw[(size_t)j * 1536 + (c >> 7) * 512 + hd * 128 + (c & 127)]; }
        cw_hd = hd;
    }
    __syncthreads();
    {
        const int i = tid >> 3, cg = tid & 7;
        const float gci = sGC[i], bei = sBE[i], gcl = sGC[63];
        const float eg = __expf(gci), ed = __expf(gcl - gci);
        const bool valid = i < nvalid;
        const int tis = n * 64 + i;
#pragma unroll
        for (int part = 0; part < 3; ++part) {
            const int col0 = part * 512 + hd * 128 + 16 * cg;
            float y[16];
#pragma unroll
            for (int e = 0; e < 16; ++e) y[e] = 0.f;
            if (valid) {
#pragma unroll
                for (int j = 0; j < 4; ++j) {
                    const int tt = tis - 3 + j;
                    float xv[16];
                    if (tt >= 0) {
                        const u32x4 a = raw[part & 1][j][0], b = raw[part & 1][j][1];
                        xv[0] = bf_lo(a.x); xv[1] = bf_hi(a.x); xv[2] = bf_lo(a.y); xv[3] = bf_hi(a.y); xv[4] = bf_lo(a.z); xv[5] = bf_hi(a.z); xv[6] = bf_lo(a.w); xv[7] = bf_hi(a.w);
                        xv[8] = bf_lo(b.x); xv[9] = bf_hi(b.x); xv[10] = bf_lo(b.y); xv[11] = bf_hi(b.y); xv[12] = bf_lo(b.z); xv[13] = bf_hi(b.z); xv[14] = bf_lo(b.w); xv[15] = bf_hi(b.w);
                    } else if (smp) {
                        const f32x4* sp = (const f32x4*)(P.in[8] + (size_t)(sq * 3 + (tt + 3)) * 1536 + col0);
#pragma unroll
                        for (int q = 0; q < 4; ++q) { const f32x4 a = sp[q]; xv[4 * q] = a[0]; xv[4 * q + 1] = a[1]; xv[4 * q + 2] = a[2]; xv[4 * q + 3] = a[3]; }
                    } else {
#pragma unroll
                        for (int e = 0; e < 16; ++e) xv[e] = 0.f;
                    }
                    const LAS f32x4* wp = (const LAS f32x4*)(sCW + j * 384 + part * 128 + 16 * cg);
#pragma unroll
                    for (int q = 0; q < 4; ++q) { const f32x4 w = wp[q]; y[4 * q] += xv[4 * q] * w[0]; y[4 * q + 1] += xv[4 * q + 1] * w[1]; y[4 * q + 2] += xv[4 * q + 2] * w[2]; y[4 * q + 3] += xv[4 * q + 3] * w[3]; }
                }
#pragma unroll
                for (int e = 0; e < 16; ++e) y[e] = y[e] / (1.0f + __expf(-y[e]));
            }
            if (part == 0) CH_LOADPART(2, 0);
            if (part < 2) {
                float ss = 0.f;
#pragma unroll
                for (int e = 0; e < 16; ++e) ss += y[e] * y[e];
                ss += swz_xor<1>(ss); ss += swz_xor<2>(ss); ss += swz_xor<4>(ss);
                const float sc_ = (1.0f / sqrtf(ss + EPS)) * (part == 0 ? 0.08838834764831843f : 1.0f);
#pragma unroll
                for (int e = 0; e < 16; ++e) y[e] *= sc_;
                u32x4 a, b;
                a.x = pk2(y[0], y[1]); a.y = pk2(y[2], y[3]); a.z = pk2(y[4], y[5]); a.w = pk2(y[6], y[7]);
                b.x = pk2(y[8], y[9]); b.y = pk2(y[10], y[11]); b.z = pk2(y[12], y[13]); b.w = pk2(y[14], y[15]);
                LAS bf16_t* dst = (part == 0 ? sQ : sK) + i * 136 + 16 * cg;
                *(LAS u32x4*)dst = a; *(LAS u32x4*)(dst + 8) = b;
                if (part == 0) {
                    u32x4 lo, hi;
                    lo.x = pk2(y[0] * eg, y[1] * eg); lo.y = pk2(y[2] * eg, y[3] * eg); lo.z = pk2(y[8] * eg, y[9] * eg); lo.w = pk2(y[10] * eg, y[11] * eg);
                    hi.x = pk2(y[4] * eg, y[5] * eg); hi.y = pk2(y[6] * eg, y[7] * eg); hi.z = pk2(y[12] * eg, y[13] * eg); hi.w = pk2(y[14] * eg, y[15] * eg);
                    const int fb = ((i >> 5) * 8 + cg) * 64 + (i & 31);
                    *(u32x4*)(gQG + (size_t)fb * 8) = lo; *(u32x4*)(gQG + (size_t)(fb + 32) * 8) = hi;
                } else {
                    const float s1 = bei * eg;
                    u32x4 c, d;
                    c.x = pk2(y[0] * s1, y[1] * s1); c.y = pk2(y[2] * s1, y[3] * s1); c.z = pk2(y[4] * s1, y[5] * s1); c.w = pk2(y[6] * s1, y[7] * s1);
                    d.x = pk2(y[8] * s1, y[9] * s1); d.y = pk2(y[10] * s1, y[11] * s1); d.z = pk2(y[12] * s1, y[13] * s1); d.w = pk2(y[14] * s1, y[15] * s1);
                    *(LAS u32x4*)(sX + i * G_XSTR + 32 * cg) = c; *(LAS u32x4*)(sX + i * G_XSTR + 32 * cg + 16) = d;
                    c.x = pk2(y[0] * ed, y[1] * ed); c.y = pk2(y[2] * ed, y[3] * ed); c.z = pk2(y[4] * ed, y[5] * ed); c.w = pk2(y[6] * ed, y[7] * ed);
                    d.x = pk2(y[8] * ed, y[9] * ed); d.y = pk2(y[10] * ed, y[11] * ed); d.z = pk2(y[12] * ed, y[13] * ed); d.w = pk2(y[14] * ed, y[15] * ed);
                    *(LAS u32x4*)(sKD + i * G_KDSTR + 32 * cg) = c; *(LAS u32x4*)(sKD + i * G_KDSTR + 32 * cg + 16) = d;
                }
            } else {
                u32x4 c, d;
                c.x = pk2(y[0] * bei, y[1] * bei); c.y = pk2(y[2] * bei, y[3] * bei); c.z = pk2(y[4] * bei, y[5] * bei); c.w = pk2(y[6] * bei, y[7] * bei);
                d.x = pk2(y[8] * bei, y[9] * bei); d.y = pk2(y[10] * bei, y[11] * bei); d.z = pk2(y[12] * bei, y[13] * bei); d.w = pk2(y[14] * bei, y[15] * bei);
                *(LAS u32x4*)(sX + i * G_XSTR + 256 + 32 * cg) = c; *(LAS u32x4*)(sX + i * G_XSTR + 256 + 32 * cg + 16) = d;
            }
        }
    }
#undef CH_LOADPART
    __syncthreads();
    const int q4 = (lane & 15) >> 2, p4 = lane & 3, g1 = (lane >> 4) & 1;
    {
        const int prod = wave >> 2, ib = (wave >> 1) & 1, jb = wave & 1;
        f32x16 acc;
#pragma unroll
        for (int e = 0; e < 16; ++e) acc[e] = 0.f;
        if (!(ib == 0 && jb == 1)) {
            const LAS bf16_t* X = prod ? sQ : sK;
#pragma unroll
            for (int ks = 0; ks < 8; ++ks) {
                const bf16x8 a = *(const LAS bf16x8*)(X + (32 * ib + r) * 136 + 16 * ks + 8 * h);
                const bf16x8 b = *(const LAS bf16x8*)(sK + (32 * jb + r) * 136 + 16 * ks + 8 * h);
                acc = MFMA32(a, b, acc);
            }
        }
        const int j = 32 * jb + r; const float gcj = sGC[j];
#pragma unroll
        for (int ii = 0; ii < 16; ++ii) {
            const int i = 32 * ib + crow(ii, h); const float gci = sGC[i];
            const float dec = __expf(fminf(gci - gcj, 0.f));
            if (prod == 0) { const float mv = (i > j) ? sBE[i] * acc[ii] * dec : 0.f; sM[i * 68 + j] = mv; if (ib == 1 && jb == 0) sM21[(i - 32) * 40 + j] = f2bf(mv); }
            else gAQK[fragpos(i, j, 64)] = f2bf((i >= j) ? acc[ii] * dec : 0.f);
        }
    }
#pragma unroll
    for (int ff = 0; ff < 2; ++ff) {
        const int f = wave * 2 + ff, kb = f >> 2, jb = (f >> 1) & 1, s = f & 1;
        const LAS unsigned char* p = sKD + (32 * jb + 16 * s + 4 * h + q4) * G_KDSTR + (32 * kb + 16 * g1) * 2 + 8 * p4;
        const s16x4 lo = vtr(p), hi = vtr(p + 8 * G_KDSTR);
        *(bf16x8*)(gKDT + ((size_t)(f * 64 + lane) << 3)) = __builtin_shufflevector(lo, hi, 0, 1, 2, 3, 4, 5, 6, 7);
    }
    __syncthreads();
    if (wave == 0) {
        int c = r, ic = 0; float T[32];
        asm volatile("" : "+v"(ic));
        const LAS float* mb_ = sM + (32 * h) * 68 + 32 * h;
        { const u32x4 z4 = {0u, 0u, 0u, 0u}; LAS bf16_t* zp = sTb + (lane >> 1) * 72 + 32 + 16 * (lane & 1); *(LAS u32x4*)zp = z4; *(LAS u32x4*)(zp + 8) = z4; }
#pragma unroll
        for (int i = 0; i < 32; ++i) {
            float a0, a1 = 0.f, a2 = 0.f, a3 = 0.f;
            asm volatile("v_cmp_eq_u32 vcc, %1, %2\n\tv_cndmask_b32 %0, 0, 1.0, vcc\n\tv_add_u32 %2, 1, %2" : "=v"(a0), "+v"(c), "+v"(ic) : : "vcc");
#pragma unroll
            for (int j = 0; j + 3 < i; j += 4) { a0 -= mb_[i * 68 + j] * T[j]; a1 -= mb_[i * 68 + j + 1] * T[j + 1]; a2 -= mb_[i * 68 + j + 2] * T[j + 2]; a3 -= mb_[i * 68 + j + 3] * T[j + 3]; }
#pragma unroll
            for (int j = (i & ~3); j < i; ++j) a0 -= mb_[i * 68 + j] * T[j];
            T[i] = (a0 + a1) + (a2 + a3);
            sTb[(32 * h + i) * 72 + 32 * h + c] = f2bf(T[i]);
        }
        if (h == 0) {
            u32x4 w_[4];
#pragma unroll
            for (int q = 0; q < 4; ++q) { w_[q].x = pk2(T[8 * q], T[8 * q + 1]); w_[q].y = pk2(T[8 * q + 2], T[8 * q + 3]); w_[q].z = pk2(T[8 * q + 4], T[8 * q + 5]); w_[q].w = pk2(T[8 * q + 6], T[8 * q + 7]); }
#pragma unroll
            for (int q = 0; q < 4; ++q) *(LAS u32x4*)(sAt + c * 40 + 8 * q) = w_[q];
        }
        f32x16 p1;
#pragma unroll
        for (int e = 0; e < 16; ++e) p1[e] = 0.f;
#pragma unroll
        for (int s = 0; s < 2; ++s) {
            const bf16x8 a = *(const LAS bf16x8*)(sM21 + r * 40 + 16 * s + 8 * h);
            const bf16x8 b = *(const LAS bf16x8*)(sAt + r * 40 + 16 * s + 8 * h);
            p1 = MFMA32(a, b, p1);
        }
        f32x16 cc;
#pragma unroll
        for (int e = 0; e < 16; ++e) cc[e] = 0.f;
#pragma unroll
        for (int s = 0; s < 2; ++s) {
            const bf16x8 pb = pack8(p1, 8 * s);
            const LAS bf16_t* ap = sTb + (32 + r) * 72 + 32 + 16 * s + 4 * h;
            const u32x2 alo = *(const LAS u32x2*)ap, ahi = *(const LAS u32x2*)(ap + 8);
            const u32x4 av = {alo.x, alo.y, ahi.x, ahi.y};
            cc = MFMA32(__builtin_bit_cast(bf16x8, av), pb, cc);
        }
#pragma unroll
        for (int ii = 0; ii < 16; ++ii) sTb[(32 + crow(ii, h)) * 72 + r] = f2bf(-cc[ii]);
    }
    __syncthreads();
    {
        const int nb = wave;
        f32x16 d[2];
#pragma unroll
        for (int ib = 0; ib < 2; ++ib)
#pragma unroll
            for (int e = 0; e < 16; ++e) d[ib][e] = 0.f;
#pragma unroll
        for (int s = 0; s < 4; ++s) {
            const LAS unsigned char* p = sX + (16 * s + 8 * h + q4) * G_XSTR + (32 * nb + 16 * g1) * 2 + 8 * p4;
            const s16x4 lo = vtr(p), hi = vtr(p + 4 * G_XSTR);
            const bf16x8 b = __builtin_shufflevector(lo, hi, 0, 1, 2, 3, 4, 5, 6, 7);
#pragma unroll
            for (int ib = 0; ib < 2; ++ib) {
                const bf16x8 a = *(const LAS bf16x8*)(sTb + (32 * ib + r) * 72 + 16 * s + 8 * h);
                d[ib] = MFMA32(a, b, d[ib]);
            }
        }
        if (nb < 4) {
#pragma unroll
            for (int ib = 0; ib < 2; ++ib)
#pragma unroll
                for (int ii = 0; ii < 16; ++ii) gNW[fragpos(32 * ib + crow(ii, h), 32 * nb + r, 128)] = f2bf(-d[ib][ii]);
        } else {
            const int dvb = nb - 4;
#pragma unroll
            for (int ib = 0; ib < 2; ++ib)
#pragma unroll
                for (int g4 = 0; g4 < 4; ++g4) { u32x2 o; o.x = pk2(d[ib][4 * g4], d[ib][4 * g4 + 1]); o.y = pk2(d[ib][4 * g4 + 2], d[ib][4 * g4 + 3]);
                    *(u32x2*)(gUT + ((size_t)(((dvb * 2 + ib) * 4 + g4) * 64 + lane)) * 4) = o; }
        }
    }
    __syncthreads();
}

__device__ __forceinline__ bf16x8 ldfrag(const bf16_t* img, int frag, int lane) { const char* b = (const char*)img + frag * 1024; return *(const bf16x8*)(b + (unsigned)(lane * 16)); }
#define SCHED_FENCE() __builtin_amdgcn_sched_barrier(0)
constexpr int SC_RING = 57344, SC_OB = 2 * SC_RING, SC_OBSZ = 64 * 128 * 2;
static_assert(SC_OB + 2 * SC_OBSZ <= LDS_BYTES, "scan LDS map");
__device__ __forceinline__ bf16x8 ldsfrag(const LAS unsigned char* img, int frag, int lane) { return *(const LAS bf16x8*)(img + frag * 1024 + lane * 16); }
__device__ __forceinline__ void scan_step(const LAS unsigned char* ring, float gl, f32x16 (&S)[4], const u32x2 (&uu)[8], LAS bf16_t* ob, int wave, int lane, int r, int h) {
    const LAS unsigned char* lNW = ring; const LAS unsigned char* lQG = ring + 16384; const LAS unsigned char* lKDT = ring + 32768; const LAS unsigned char* lAQK = ring + 49152;
    bf16x8 sb[4][2];
#pragma unroll
    for (int kb = 0; kb < 4; ++kb) { sb[kb][0] = pack8(S[kb], 0); sb[kb][1] = pack8(S[kb], 8); }
    f32x16 VN[2];
#pragma unroll
    for (int ib = 0; ib < 2; ++ib)
#pragma unroll
        for (int g4 = 0; g4 < 4; ++g4) { const u32x2 u2 = uu[ib * 4 + g4];
            VN[ib][4 * g4] = bf_lo(u2.x); VN[ib][4 * g4 + 1] = bf_hi(u2.x); VN[ib][4 * g4 + 2] = bf_lo(u2.y); VN[ib][4 * g4 + 3] = bf_hi(u2.y); }
#pragma unroll
    for (int kb = 0; kb < 4; ++kb)
#pragma unroll
        for (int s = 0; s < 2; ++s)
#pragma unroll
            for (int ib = 0; ib < 2; ++ib) VN[ib] = MFMA32(ldsfrag(lNW, ib * 8 + kb * 2 + s, lane), sb[kb][s], VN[ib]);
    f32x16 Oa[2];
#pragma unroll
    for (int ib = 0; ib < 2; ++ib)
#pragma unroll
        for (int ii = 0; ii < 16; ++ii) Oa[ib][ii] = 0.f;
#pragma unroll
    for (int kb = 0; kb < 4; ++kb)
#pragma unroll
        for (int s = 0; s < 2; ++s)
#pragma unroll
            for (int ib = 0; ib < 2; ++ib) Oa[ib] = MFMA32(ldsfrag(lQG, ib * 8 + kb * 2 + s, lane), sb[kb][s], Oa[ib]);
    SCHED_FENCE();
    bf16x8 vnb[2][2];
#pragma unroll
    for (int jb = 0; jb < 2; ++jb) { vnb[jb][0] = pack8(VN[jb], 0); vnb[jb][1] = pack8(VN[jb], 8); }
#pragma unroll
    for (int jb = 0; jb < 2; ++jb)
#pragma unroll
        for (int s = 0; s < 2; ++s)
#pragma unroll
            for (int ib = 0; ib < 2; ++ib) Oa[ib] = MFMA32(ldsfrag(lAQK, ib * 4 + jb * 2 + s, lane), vnb[jb][s], Oa[ib]);
#pragma unroll
    for (int kb = 0; kb < 4; ++kb) S[kb] = S[kb] * gl;
#pragma unroll
    for (int jb = 0; jb < 2; ++jb)
#pragma unroll
        for (int s = 0; s < 2; ++s)
#pragma unroll
            for (int kb = 0; kb < 4; ++kb) S[kb] = MFMA32(ldsfrag(lKDT, kb * 4 + jb * 2 + s, lane), vnb[jb][s], S[kb]);
    SCHED_FENCE();
#pragma unroll
    for (int ib = 0; ib < 2; ++ib)
#pragma unroll
        for (int ii = 0; ii < 16; ++ii) ob[(32 * ib + crow(ii, h)) * 128 + 32 * wave + r] = f2bf(Oa[ib][ii]);
}
__device__ __forceinline__ void scan_unit(const Params& P, LAS unsigned char* lds, int su) {
    const int tid = threadIdx.x, lane = tid & 63, wave = __builtin_amdgcn_readfirstlane(tid >> 6), r = lane & 31, h = lane >> 5;
    unsigned char* ws = P.ws;
    const bool smp = su >= 32; const int hd = su & 3; const int sq = smp ? ((su - 32) >> 2) : (su >> 2);
    const int nsteps = smp ? 1 : 128;
    const int unit0 = smp ? NCHUNK_P * 4 + sq * 4 + hd : (sq * 128) * 4 + hd;
    const int tok0 = smp ? MP + sq * TS : sq * TP; const int nvalid = smp ? TS : 64;
    const float* GL = (const float*)(ws + WS_GL);
    const unsigned char* ch0 = ws + WS_CH + (size_t)unit0 * CH_BYTES;
    __syncthreads();
    if (wave < 4) {
        f32x16 S[4];
#pragma unroll
        for (int kb = 0; kb < 4; ++kb)
#pragma unroll
            for (int ii = 0; ii < 16; ++ii) S[kb][ii] = 0.f;
        if (smp) {
            const float* st = P.in[7] + (size_t)(sq * 4 + hd) * 16384;
#pragma unroll
            for (int kb = 0; kb < 4; ++kb)
#pragma unroll
                for (int ii = 0; ii < 16; ++ii) S[kb][ii] = st[(size_t)(32 * kb + crow(ii, h)) * 128 + 32 * wave + r];
        }
        u32x2 uu[8], un[8];
#pragma unroll
        for (int i = 0; i < 8; ++i) uu[i] = *(const u32x2*)(ch0 + 49152 + (wave * 8 + i) * 512 + (unsigned)(lane * 8));
        __syncthreads();
        for (int n = 0; n < nsteps; ++n) {
            if (n + 1 < nsteps) {
                const unsigned char* chn = ch0 + (size_t)(n + 1) * 4 * CH_BYTES;
#pragma unroll
                for (int i = 0; i < 8; ++i) un[i] = *(const u32x2*)(chn + 49152 + (wave * 8 + i) * 512 + (unsigned)(lane * 8));
            }
            scan_step(lds + (n & 1) * SC_RING, GL[unit0 + n * 4], S, uu, (LAS bf16_t*)(lds + SC_OB + (n & 1) * SC_OBSZ), wave, lane, r, h);
#pragma unroll
            for (int i = 0; i < 8; ++i) uu[i] = un[i];
            __syncthreads();
        }
        float* so = P.out + (smp ? O_SSTATE : O_PSTATE) + (size_t)(sq * 4 + hd) * 16384;
#pragma unroll
        for (int kb = 0; kb < 4; ++kb)
#pragma unroll
            for (int ii = 0; ii < 16; ++ii) so[(size_t)(32 * kb + crow(ii, h)) * 128 + 32 * wave + r] = S[kb][ii];
        __syncthreads();
    } else {
        int t2 = tid - 256; asm volatile("" : "+v"(t2));
        const int ni = t2 >> 2, ncg = t2 & 3, w4 = wave - 4, ln = t2 & 63;
        const float* gnorm = P.in[14];
        f32x4 gq[8];
#pragma unroll
        for (int q = 0; q < 8; ++q) gq[q] = *(const f32x4*)(gnorm + 32 * ncg + 4 * q);
#define SC_DMA(chb_, ringoff_) do { _Pragma("unroll") for (int i_ = 0; i_ < 14; ++i_) { const int o_ = w4 + 4 * i_; const int so_ = o_ < 48 ? o_ * 1024 : 65536 + (o_ - 48) * 1024; \
        __builtin_amdgcn_global_load_lds((const unsigned*)((chb_) + so_ + ln * 16), (LAS unsigned*)(lds + (ringoff_) + o_ * 1024), 16, 0, 0); } } while (0)
        SC_DMA(ch0, 0);
        __syncthreads();
        for (int n = 0; n <= nsteps; ++n) {
            if (n + 1 < nsteps) { const unsigned char* chn = ch0 + (size_t)(n + 1) * 4 * CH_BYTES; SC_DMA(chn, ((n + 1) & 1) * SC_RING); }
            if (n >= 1) {
                const int m = n - 1;
                const LAS bf16_t* ob = (const LAS bf16_t*)(lds + SC_OB + (m & 1) * SC_OBSZ) + ni * 128 + 32 * ncg;
                float o[32]; float ss = 0.f;
#pragma unroll
                for (int q = 0; q < 4; ++q) { const u32x4 v = *(const LAS u32x4*)(ob + 8 * q);
                    o[8 * q] = bf_lo(v.x); o[8 * q + 1] = bf_hi(v.x); o[8 * q + 2] = bf_lo(v.y); o[8 * q + 3] = bf_hi(v.y); o[8 * q + 4] = bf_lo(v.z); o[8 * q + 5] = bf_hi(v.z); o[8 * q + 6] = bf_lo(v.w); o[8 * q + 7] = bf_hi(v.w); }
#pragma unroll
                for (int e = 0; e < 32; ++e) ss += o[e] * o[e];
                ss += swz_xor<1>(ss); ss += swz_xor<2>(ss);
                const float rstd = 1.0f / sqrtf(ss * (1.0f / 128.0f) + EPS);
                if (ni < nvalid) {
                    const size_t row = (size_t)(tok0 + m * 64 + ni);
                    const u32x4* zp = (const u32x4*)((const bf16_t*)(ws + WS_Z) + row * 512 + hd * 128 + 32 * ncg);
                    bf16_t* mp = (bf16_t*)(ws + WS_R1) + row * DM + hd * 128 + 32 * ncg;
#pragma unroll
                    for (int q = 0; q < 4; ++q) {
                        const u32x4 zz = zp[q]; float zv[8];
                        zv[0] = bf_lo(zz.x); zv[1] = bf_hi(zz.x); zv[2] = bf_lo(zz.y); zv[3] = bf_hi(zz.y); zv[4] = bf_lo(zz.z); zv[5] = bf_hi(zz.z); zv[6] = bf_lo(zz.w); zv[7] = bf_hi(zz.w);
                        float ov[8];
#pragma unroll
                        for (int e = 0; e < 8; ++e) { const float z1 = zv[e]; ov[e] = o[8 * q + e] * rstd * gq[2 * q + (e >> 2)][e & 3] * (z1 / (1.0f + __expf(-z1))); }
                        u32x4 a; a.x = pk2(ov[0], ov[1]); a.y = pk2(ov[2], ov[3]); a.z = pk2(ov[4], ov[5]); a.w = pk2(ov[6], ov[7]);
                        *(u32x4*)(mp + 8 * q) = a;
                    }
                }
            }
            __syncthreads();
        }
#undef SC_DMA
    }
}
constexpr int A_KB = 0, A_VB = 3 * 17408, A_VSTR = 320, A_VBUF = 64 * A_VSTR, A_MB = 131072, A_LB = 131072 + 2048;
__device__ __forceinline__ float max3f(float a, float b, float c) { float r; asm("v_max3_f32 %0, %1, %2, %3" : "=v"(r) : "v"(a), "v"(b), "v"(c)); return r; }
template <bool DIFF>
__device__ __forceinline__ void attn_unit(LAS unsigned char* lds, const bf16_t* __restrict__ qrow, const bf16_t* __restrict__ kbase, const bf16_t* __restrict__ vbase,
                                          int NT, int nkeys, bool split, int my_lim, bf16_t* obase, int ldo, float lam, const float* __restrict__ gain) {
    constexpr int NM = DIFF ? 2 : 1, KS = DIFF ? 4 : 8, NG = DIFF ? 4 : 8;
    const int tid = threadIdx.x, lane = tid & 63, wave = __builtin_amdgcn_readfirstlane(tid >> 6), r = lane & 31, h = lane >> 5;
    const int mp = DIFF ? (wave & 1) : 0, grp = DIFF ? (wave >> 1) : wave;
    bf16x8 bq[KS];
#pragma unroll
    for (int f = 0; f < KS; ++f) bq[f] = *(const bf16x8*)(qrow + mp * 64 + f * 16 + h * 8);
    float m_ = -INFINITY; f32x16 O[4], lacc;
    const bf16x8 ones = {0x3F80, 0x3F80, 0x3F80, 0x3F80, 0x3F80, 0x3F80, 0x3F80, 0x3F80};
#pragma unroll
    for (int ii = 0; ii < 16; ++ii) lacc[ii] = 0.f;
#pragma unroll
    for (int db = 0; db < 4; ++db)
#pragma unroll
        for (int ii = 0; ii < 16; ++ii) O[db][ii] = 0.f;
    int goff[5];
#pragma unroll
    for (int i = 0; i < 5; ++i) { int op = wave + 8 * i; op = op > 36 ? 36 : op; const bool isk = op < 17; const int slot = (isk ? op : op - 17) * 64 + lane; const int per = isk ? 17 : 20;
        const int row = slot / per; int pcs = slot - row * per; pcs = pcs > 15 ? 15 : pcs; goff[i] = (row << 10) | (pcs << 4); }
#define A_DMA(t, kb_, vb_) do { _Pragma("unroll") for (int i_ = 0; i_ < 5; ++i_) { int op_ = wave + 8 * i_; op_ = op_ > 36 ? 36 : op_; const bool isk_ = op_ < 17; \
        int key_ = (t) * 64 + (goff[i_] >> 10); key_ = key_ < nkeys ? key_ : nkeys - 1; \
        const char* g_ = (const char*)(isk_ ? kbase : vbase) + (size_t)key_ * 1024 + (goff[i_] & 1023); \
        LAS unsigned char* d_ = lds + (isk_ ? A_KB + (kb_) * 17408 + op_ * 1024 : A_VB + (vb_) * A_VBUF + (op_ - 17) * 1024); \
        __builtin_amdgcn_global_load_lds((const unsigned*)g_, (LAS unsigned*)d_, 16, 0, 0); } } while (0)
#define A_WAITBAR(N) asm volatile("s_waitcnt vmcnt(" #N ") lgkmcnt(0)\n\ts_barrier" ::: "memory")
    __syncthreads();
    asm volatile("s_waitcnt vmcnt(0)" ::: "memory");
    A_DMA(0, 0, 0);
    A_WAITBAR(0);
    const int q4 = (lane & 15) >> 2, p4 = lane & 3, g1 = (lane >> 4) & 1;
    const LAS unsigned char* vb0 = lds + A_VB + (4 * h + q4) * A_VSTR + 32 * g1 + 8 * p4;
#define A_PV(vbuf) do { const LAS unsigned char* vb_l = vb0 + (vbuf) * A_VBUF; \
        _Pragma("unroll") for (int db = 0; db < 4; ++db) _Pragma("unroll") for (int kh = 0; kh < 2; ++kh) _Pragma("unroll") for (int s = 0; s < 2; ++s) { \
            const s16x4 lo = vtr(vb_l + (32 * kh + 16 * s) * A_VSTR + 64 * db); const s16x4 hi = vtr(vb_l + (32 * kh + 16 * s + 8) * A_VSTR + 64 * db); \
            const bf16x8 vf = __builtin_shufflevector(lo, hi, 0, 1, 2, 3, 4, 5, 6, 7); O[db] = MFMA32(vf, pk[kh][s], O[db]); if (db == 0) lacc = MFMA32(ones, pk[kh][s], lacc); } } while (0)
    const bool late = false;
    bool first = true, pact = false;
    bf16x8 pk[2][2];
    int k3 = 0;
    for (int t = 0; t < NT; ++t) {
        const int k3n = (k3 == 2) ? 0 : k3 + 1, k3nn = (k3n == 2) ? 0 : k3n + 1;
        if (t + 1 < NT) A_DMA(t + 1, k3n, (t + 1) & 3);
        if (late && pact) A_PV((t - 1) & 3);
        const bool active = split ? ((t % NG) == grp) : (t <= my_lim);
        if (active) {
            const LAS unsigned char* kbuf = lds + A_KB + k3 * 17408 + mp * 128;
            const float cin = first ? 0.f : -m_;
            f32x16 s0, s1;
#pragma unroll
            for (int ii = 0; ii < 16; ++ii) { s0[ii] = cin; s1[ii] = cin; }
#pragma unroll
            for (int ks = 0; ks < KS; ++ks) {
                const bf16x8 a0 = *(const LAS bf16x8*)(kbuf + r * 272 + (ks * 16 + h * 8) * 2);
                const bf16x8 a1 = *(const LAS bf16x8*)(kbuf + (32 + r) * 272 + (ks * 16 + h * 8) * 2);
                s0 = MFMA32(a0, bq[ks], s0); s1 = MFMA32(a1, bq[ks], s1);
            }
            if (t * 64 + 64 > nkeys) {
#pragma unroll
                for (int ii = 0; ii < 16; ++ii) { const int key = t * 64 + crow(ii, h); if (key >= nkeys) s0[ii] = -INFINITY; if (key + 32 >= nkeys) s1[ii] = -INFINITY; }
            }
            asm volatile("s_nop 15\n\ts_nop 7" : "+v"(s0), "+v"(s1));
            float mx;
            {
                float a0 = max3f(s0[0], s0[1], s0[2]), a1 = max3f(s0[3], s0[4], s0[5]), a2 = max3f(s0[6], s0[7], s0[8]), a3 = max3f(s0[9], s0[10], s0[11]);
                float b0 = max3f(s1[0], s1[1], s1[2]), b1 = max3f(s1[3], s1[4], s1[5]), b2 = max3f(s1[6], s1[7], s1[8]), b3 = max3f(s1[9], s1[10], s1[11]);
                a0 = max3f(a0, s0[12], s0[13]); a1 = max3f(a1, s0[14], s0[15]); b0 = max3f(b0, s1[12], s1[13]); b1 = max3f(b1, s1[14], s1[15]);
                a0 = max3f(a0, a1, a2); b0 = max3f(b0, b1, b2); mx = max3f(a0, b0, a3); mx = max3f(mx, b3, b3);
            }
            mx = half_max(mx);
            if (first || __any(mx > 6.0f)) {
                const float dl = first ? mx : ((mx > 6.0f) ? mx : 0.f);
                const float alpha = first ? 1.0f : __builtin_amdgcn_exp2f(-dl);
                m_ = first ? mx : m_ + dl; first = false;
                lacc = lacc * alpha;
#pragma unroll
                for (int ii = 0; ii < 16; ++ii) { s0[ii] -= dl; s1[ii] -= dl; }
#pragma unroll
                for (int db = 0; db < 4; ++db) O[db] = O[db] * alpha;
            }
#pragma unroll
            for (int ii = 0; ii < 16; ++ii) { s0[ii] = __builtin_amdgcn_exp2f(s0[ii]); s1[ii] = __builtin_amdgcn_exp2f(s1[ii]); }
            pk[0][0] = pack8(s0, 0); pk[0][1] = pack8(s0, 8); pk[1][0] = pack8(s1, 0); pk[1][1] = pack8(s1, 8);
        }
        if (!late && active) A_PV(t & 3);
        pact = active; k3 = k3n;
        A_WAITBAR(0);
    }
    if (late && pact) A_PV((NT - 1) & 3);
    __syncthreads();
#undef A_PV
#undef A_DMA
#undef A_WAITBAR
    LAS float* red = (LAS float*)lds;
    LAS float* mb = (LAS float*)(lds + A_MB); LAS float* lb = (LAS float*)(lds + A_LB);
    float l_ = lacc[0];
    bool have = true;
    if (split) {
        if (h == 0) mb[wave * 32 + r] = m_;
        __syncthreads();
        float M = mb[mp * 32 + r];
#pragma unroll
        for (int g = 1; g < NG; ++g) M = fmaxf(M, mb[(g * NM + mp) * 32 + r]);
        const float f = __builtin_amdgcn_exp2f(m_ - M);
        l_ *= f;
        if (h == 0) lb[wave * 32 + r] = l_;
#pragma unroll
        for (int db = 0; db < 4; ++db)
#pragma unroll
            for (int ii = 0; ii < 16; ++ii) red[(wave * 64 + db * 16 + ii) * 64 + lane] = O[db][ii] * f;
        __syncthreads();
        have = wave < NM;
        if (have) {
#pragma unroll
            for (int db = 0; db < 4; ++db)
#pragma unroll
                for (int ii = 0; ii < 16; ++ii) { float a = 0.f;
#pragma unroll
                    for (int g = 0; g < NG; ++g) a += red[((g * NM + mp) * 64 + db * 16 + ii) * 64 + lane];
                    O[db][ii] = a; }
            float lt = 0.f;
#pragma unroll
            for (int g = 0; g < NG; ++g) lt += lb[(g * NM + mp) * 32 + r];
            l_ = lt;
        }
        __syncthreads();
    }
    const float linv = 1.0f / l_;
    LAS unsigned char* stg = lds + wave * 8704;
    bool wr = false;
    if (DIFF) {
        if (have && mp == 1) {
#pragma unroll
            for (int db = 0; db < 4; ++db)
#pragma unroll
                for (int ii = 0; ii < 16; ++ii) red[(grp * 64 + db * 16 + ii) * 64 + lane] = O[db][ii] * linv;
        }
        __syncthreads();
        float rstd = 0.f;
        if (have && mp == 0) {
            float ss = 0.f;
#pragma unroll
            for (int db = 0; db < 4; ++db)
#pragma unroll
                for (int ii = 0; ii < 16; ++ii) { const float v = O[db][ii] * linv - lam * red[(grp * 64 + db * 16 + ii) * 64 + lane]; O[db][ii] = v; ss += v * v; }
            ss = half_sum(ss);
            rstd = (1.0f / sqrtf(ss * (1.0f / 128.0f) + EPS)) * 0.8f;
        }
        __syncthreads();
        if (have && mp == 0) {
            wr = true;
#pragma unroll
            for (int db = 0; db < 4; ++db)
#pragma unroll
                for (int g4 = 0; g4 < 4; ++g4) {
                    const int dv = 32 * db + 8 * g4 + 4 * h;
                    const f32x4 g = *(const f32x4*)(gain + dv);
                    u32x2 o; o.x = pk2(O[db][4 * g4] * rstd * g[0], O[db][4 * g4 + 1] * rstd * g[1]); o.y = pk2(O[db][4 * g4 + 2] * rstd * g[2], O[db][4 * g4 + 3] * rstd * g[3]);
                    *(LAS u32x2*)(stg + r * 272 + dv * 2) = o;
                }
        }
    } else {
        if (have) {
            wr = true;
#pragma unroll
            for (int db = 0; db < 4; ++db)
#pragma unroll
                for (int g4 = 0; g4 < 4; ++g4) {
                    const int dv = 32 * db + 8 * g4 + 4 * h;
                    u32x2 o; o.x = pk2(O[db][4 * g4] * linv, O[db][4 * g4 + 1] * linv); o.y = pk2(O[db][4 * g4 + 2] * linv, O[db][4 * g4 + 3] * linv);
                    *(LAS u32x2*)(stg + r * 272 + dv * 2) = o;
                }
        }
    }
    if (wr) {
#pragma unroll
        for (int i = 0; i < 8; ++i) {
            const int row = 4 * i + (lane >> 4), pc16 = lane & 15;
            const u32x4 v = *(const LAS u32x4*)(stg + row * 272 + pc16 * 16);
            *(u32x4*)(obase + (size_t)row * ldo + pc16 * 8) = v;
        }
    }
}
#ifndef MK_REP
#define MK_REP (-1)
#endif
constexpr int N_PHASES = 8;
__device__ __forceinline__ void wait_counter(unsigned* w, unsigned target) {
    __syncthreads();
    if (threadIdx.x == 0) { while (__hip_atomic_load(w, __ATOMIC_RELAXED, __HIP_MEMORY_SCOPE_AGENT) < target) __builtin_amdgcn_s_sleep(4); __builtin_amdgcn_fence(__ATOMIC_ACQUIRE, "agent"); }
    __syncthreads();
}
__device__ __forceinline__ void grid_barrier(unsigned* ctr, unsigned target) {
    asm volatile("s_waitcnt vmcnt(0)" ::: "memory");
    __syncthreads();
    if (threadIdx.x == 0) {
        __builtin_amdgcn_fence(__ATOMIC_RELEASE, "agent");
        const unsigned old = __hip_atomic_fetch_add(ctr, 1u, __ATOMIC_RELAXED, __HIP_MEMORY_SCOPE_AGENT);
        if (old + 1u == target) { __builtin_amdgcn_fence(__ATOMIC_ACQ_REL, "agent"); __hip_atomic_store(ctr + 32, target, __ATOMIC_RELAXED, __HIP_MEMORY_SCOPE_AGENT); }
        else while (__hip_atomic_load(ctr + 32, __ATOMIC_RELAXED, __HIP_MEMORY_SCOPE_AGENT) < target) __builtin_amdgcn_s_sleep(8);
        __builtin_amdgcn_fence(__ATOMIC_ACQUIRE, "agent");
    }
    __syncthreads();
}
constexpr int N_DIFF_P = NBP * 4 * (TP / 128);
constexpr int N_DIFF_UNITS = N_DIFF_P + NBS * 4;
__global__ void __launch_bounds__(512, 2) mk_fwd(Params P) {
    extern __shared__ __attribute__((aligned(16))) unsigned char lds_raw[];
    LAS unsigned char* lds = (LAS unsigned char*)lds_raw;
    const int tid = threadIdx.x, lane = tid & 63, wave = __builtin_amdgcn_readfirstlane(tid >> 6), r = lane & 31;
    unsigned char* ws = P.ws;
    const int lo = P.ph_lo, hi = P.ph_hi, G = gridDim.x;
#ifndef MK_PHMASK
#define MK_PHMASK 0xff
#endif
#define IN(k) (((MK_PHMASK >> (k)) & 1) && lo <= (k) && (k) < hi)
#define SEAM(k) do { if (IN(k) && IN((k) + 1)) { grid_barrier((unsigned*)(ws + WS_BAR), (unsigned)G * (unsigned)(++nbar)); } } while (0)
    int nbar = 0;
#define PH_BEGIN(k) if (IN(k)) {
#define PH_END }
    if (P.ph_hi < 0) cg::this_grid().sync();
    PH_BEGIN(0) p0_prologue(P, lds); PH_END
    SEAM(0);
    PH_BEGIN(1) {
        {
            pg8::Gemm g{(const bf16_t*)(ws + WS_R1), (const bf16_t*)(ws + WS_WIN), MP, NIN, DM, DM}; pg8::StaticOrder S; S.init(MP, NIN, G, (int)blockIdx.x);
            pg8::EpiIn E{(bf16_t*)(ws + WS_QKVPRE), (bf16_t*)(ws + WS_Z), (bf16_t*)(ws + WS_QD), (bf16_t*)(ws + WS_KB), (bf16_t*)(ws + WS_VB), P.out, (const float*)(ws + WS_ROPE)};
            pg8::gemm_phase<pg8::EpiIn, pg8::StaticOrder, true, true>(lds, g, S, E);
        }
    } PH_END
    SEAM(1);
    PH_BEGIN(2) { int cw_hd = -1; for (int U = blockIdx.x; U < NCHUNK_P * 4; U += G) chunk_unit(P, lds, U, cw_hd); } PH_END
    SEAM(2);
    PH_BEGIN(3) {
        if (P.sub & 1) { for (int su = blockIdx.x; su < 96; su += G) { if (su >= 32) wait_counter((unsigned*)(ws + WS_CTR) + 160, 64u); scan_unit(P, lds, su);
            if (su >= 32) { asm volatile("s_waitcnt vmcnt(0)" ::: "memory"); __syncthreads(); if (tid == 0) { __builtin_amdgcn_fence(__ATOMIC_RELEASE, "agent"); __hip_atomic_fetch_add((unsigned*)(ws + WS_CTR) + 128, 1u, __ATOMIC_RELAXED, __HIP_MEMORY_SCOPE_AGENT); } } } }
        if ((P.sub & 2) && G >= 160 && blockIdx.x >= 128 && blockIdx.x < 160) {
            const int tc = (int)blockIdx.x - 128; unsigned* cw = (unsigned*)(ws + WS_CTR);
            int tb = 0;
#define TEAM_WAIT(word, target) do { asm volatile("s_waitcnt vmcnt(0)" ::: "memory"); __syncthreads(); if (threadIdx.x == 0) { __builtin_amdgcn_fence(__ATOMIC_RELEASE, "agent"); \
            while (__hip_atomic_load(cw + (word), __ATOMIC_RELAXED, __HIP_MEMORY_SCOPE_AGENT) < (unsigned)(target)) __builtin_amdgcn_s_sleep(4); \
            __builtin_amdgcn_fence(__ATOMIC_ACQUIRE, "agent"); } __syncthreads(); } while (0)
#define TEAM_BAR() do { asm volatile("s_waitcnt vmcnt(0)" ::: "memory"); __syncthreads(); if (threadIdx.x == 0) { __builtin_amdgcn_fence(__ATOMIC_RELEASE, "agent"); __hip_atomic_fetch_add(cw + 160, 1u, __ATOMIC_RELAXED, __HIP_MEMORY_SCOPE_AGENT); } ++tb; TEAM_WAIT(160, 32 * tb); } while (0)
#define XBv ((bf16_t*)(P.ws + WS_XBS) - (size_t)MP * DM)
#define QMv ((bf16_t*)(P.ws + WS_QMS) - (size_t)MP * 512)
#define Hv ((bf16_t*)(P.ws + WS_HS) - (size_t)MP * DFF)
            {
                pg8::Gemm g{(const bf16_t*)(ws + WS_R1), (const bf16_t*)(ws + WS_WIN), MT, NIN, DM, DM}; pg8::TeamOrder S; S.init(MP / 256, MS / 256, NIN / 256, 32, tc);
                pg8::EpiIn E{(bf16_t*)(ws + WS_QKVPRE), (bf16_t*)(ws + WS_Z), (bf16_t*)(ws + WS_QD), (bf16_t*)(ws + WS_KB), (bf16_t*)(ws + WS_VB), P.out, (const float*)(ws + WS_ROPE)};
                pg8::gemm_phase<pg8::EpiIn, pg8::TeamOrder, true, true>(lds, g, S, E);
            }
            TEAM_BAR();
            { int cw_hd = -1; for (int cu = tc; cu < NBS * 4; cu += 32) chunk_unit(P, lds, NCHUNK_P * 4 + cu, cw_hd); }
            TEAM_BAR();
            TEAM_WAIT(128, 128);
            {
                pg8::Gemm g{(const bf16_t*)(ws + WS_R1), (const bf16_t*)(ws + WS_WOUT), MT, DM, DM, DM}; pg8::TeamOrder S; S.init(MP / 256, MS / 256, DM / 256, 32, tc);
                pg8::EpiRes E{P.in[0], P.in[1], P.out + O_Y, XBv, (float*)(ws + WS_SSQ)};
                pg8::gemm_phase<pg8::EpiRes, pg8::TeamOrder, true, true>(lds, g, S, E);
            }
            TEAM_BAR();
            {
                pg8::Gemm g{XBv, (const bf16_t*)(ws + WS_WMQ), MT, 512, DM, DM}; pg8::TeamOrder S; S.init(MP / 256, MS / 256, 2, 32, tc);
                pg8::EpiScale<0> E{QMv, 512, (const float*)(ws + WS_SSQ), QSCALE_M};
                pg8::gemm_phase<pg8::EpiScale<0>, pg8::TeamOrder, true, true>(lds, g, S, E);
            }
            TEAM_BAR();
            for (int su = tc; su < NBS * 4; su += 32) {
                const int s = su >> 2, hd = su & 3; const size_t row0 = (size_t)MP + s * TS, row = row0 + r;
                attn_unit<false>(lds, QMv + row * 512 + hd * 128, (const bf16_t*)(ws + WS_KM) + (size_t)(NBP * NMEM + s * NMEM) * 512 + hd * 128, (const bf16_t*)(ws + WS_VM) + (size_t)(NBP * NMEM + s * NMEM) * 512 + hd * 128,
                                 4, NMEM, true, 0, QMv + row0 * 512 + hd * 128, 512, 0.f, nullptr);
            }
            TEAM_BAR();
            {
                pg8::Gemm g{QMv, (const bf16_t*)(ws + WS_WMO), MT, DM, 512, 512}; pg8::TeamOrder S; S.init(MP / 256, MS / 256, DM / 256, 32, tc);
                pg8::EpiRes E{P.out + O_Y, P.out + O_Y + (size_t)MP * DM, P.out + O_Y, XBv, (float*)(ws + WS_SSQ)};
                pg8::gemm_phase<pg8::EpiRes, pg8::TeamOrder, true, true>(lds, g, S, E);
            }
            TEAM_BAR();
            {
                pg8::Gemm g{XBv, (const bf16_t*)(ws + WS_WUP), MT, DFF, DM, DM}; pg8::TeamOrder S; S.init(MP / 256, MS / 256, DFF / 256, 32, tc);
                pg8::EpiScale<1> E{Hv, DFF, (const float*)(ws + WS_SSQ), 1.0f};
                pg8::gemm_phase<pg8::EpiScale<1>, pg8::TeamOrder, true, true>(lds, g, S, E);
            }
            TEAM_BAR();
            {
                pg8::Gemm g{Hv, (const bf16_t*)(ws + WS_WDN), MT, DM, DFF, DFF}; pg8::TeamOrder S; S.init(MP / 256, MS / 256, DM / 256, 32, tc);
                pg8::EpiRes E{P.out + O_Y, P.out + O_Y + (size_t)MP * DM, P.out + O_Y, nullptr, nullptr};
                pg8::gemm_phase<pg8::EpiRes, pg8::TeamOrder, true, true>(lds, g, S, E);
            }
            TEAM_BAR();
            {
                const float* gf = P.in[26];
                for (int m = MP + tc * 8 + wave; m < MT; m += 32 * 8) {
                    f32x4* yp = (f32x4*)(P.out + O_Y + (size_t)m * DM);
                    f32x4 v[4]; float ss = 0.f;
#pragma unroll
                    for (int j = 0; j < 4; ++j) { v[j] = yp[64 * j + lane]; ss += (v[j][0] * v[j][0] + v[j][1] * v[j][1]) + (v[j][2] * v[j][2] + v[j][3] * v[j][3]); }
                    const float rstd = 1.0f / sqrtf(wave_sum(ss) * (1.0f / DM) + EPS);
#pragma unroll
                    for (int j = 0; j < 4; ++j) yp[64 * j + lane] = v[j] * rstd * ((const f32x4*)gf)[64 * j + lane];
                }
            }
            __syncthreads();
#undef TEAM_WAIT
#undef TEAM_BAR
#undef XBv
#undef QMv
#undef Hv
        }
        if ((P.sub & 2) && G >= 192 && blockIdx.x >= 160 && blockIdx.x < 192) {
            const int mu = (int)blockIdx.x - 160;
            pg8::Gemm g{(const bf16_t*)(ws + WS_MH), (const bf16_t*)(ws + WS_WMKV), NBP * NMEM, 1024, DM, DM}; pg8::OneUnit S{mu >> 2, mu & 3};
            pg8::EpiMem E{(bf16_t*)(ws + WS_KM), (bf16_t*)(ws + WS_VM), P.out};
            pg8::gemm_phase<pg8::EpiMem, pg8::OneUnit, false, true>(lds, g, S, E);
            __syncthreads();
        }
        float lam;
        { const float* lf = P.in[15]; const float s1 = wave_sum(lf[lane] * lf[64 + lane]), s2 = wave_sum(lf[128 + lane] * lf[192 + lane]); lam = expf(s1) - expf(s2) + 0.2f; }
        LAS int* qslot = (LAS int*)(lds + LDS_BYTES - 64);
        unsigned* ctr = (unsigned*)(ws + WS_CTR);
        const int x0 = (int)(__builtin_amdgcn_s_getreg((3 << 11) | 20) & 7u);
        int att = 0;
        for (;;) {
            __syncthreads();
            if (tid == 0) {
                int code = -1;
                while (att < 8) { const int x = (x0 + att) & 7; const int j = (int)atomicAdd(ctr + x * 16, 1u); if (j < 264) { code = x * 512 + j; break; } ++att; }
                qslot[0] = code; qslot[1] = att;
            }
            __syncthreads();
            const int code = qslot[0]; att = qslot[1];
            if (code < 0 || !(P.sub & 2)) break;
            const int qx = code >> 9, qj = code & 511;
            const int qp = qj < 8 ? qj : qj - 8;
            const int u = (qj >= 8 && qj < 16) ? N_DIFF_P + 8 * qx + (qj - 8) : ((qp >> 2) << 5) + 4 * qx + (qp & 3);
            const bf16_t *qrow, *kbase, *vbase; bf16_t* orow; int NT, nkeys, my_lim; bool split;
            const int grp = wave >> 1;
            int rr = r; asm volatile("" : "+v"(rr));
            if (u < N_DIFF_P) {
                const int qb = 63 - (u >> 5), b = (u & 31) >> 2, hd = u & 3;
                const size_t row0 = (size_t)b * TP + qb * 128 + 32 * grp, row = row0 + rr;
                qrow = (const bf16_t*)(ws + WS_QD) + row * 512 + hd * 128;
                kbase = (const bf16_t*)(ws + WS_KB) + (size_t)b * TP * 512 + hd * 128; vbase = (const bf16_t*)(ws + WS_VB) + (size_t)b * TP * 512 + hd * 128;
                NT = 2 * qb + 2; nkeys = NT * 64; my_lim = 2 * qb + (grp >> 1); split = false;
                orow = (bf16_t*)(ws + WS_R1) + row0 * DM + 512 + hd * 128;
            } else {
                const int s = (u - N_DIFF_P) >> 2, hd = u & 3;
                const size_t row0 = (size_t)MP + s * TS, row = row0 + rr;
                qrow = (const bf16_t*)(ws + WS_QD) + row * 512 + hd * 128;
                kbase = (const bf16_t*)(ws + WS_KB) + ((size_t)MP + (size_t)s * SKV) * 512 + hd * 128; vbase = (const bf16_t*)(ws + WS_VB) + ((size_t)MP + (size_t)s * SKV) * 512 + hd * 128;
                NT = (SKV + 63) / 64; nkeys = SKV; my_lim = 0; split = true;
                orow = (bf16_t*)(ws + WS_R1) + row0 * DM + 512 + hd * 128;
            }
#ifndef MK_NODIFF
            if (u >= N_DIFF_P) wait_counter(ctr + 160, 32u);
            attn_unit<true>(lds, qrow, kbase, vbase, NT, nkeys, split, my_lim, orow, DM, lam, P.in[16]);
#endif
            if (u >= N_DIFF_P) { asm volatile("s_waitcnt vmcnt(0)" ::: "memory"); __syncthreads(); if (tid == 0) { __builtin_amdgcn_fence(__ATOMIC_RELEASE, "agent"); __hip_atomic_fetch_add(ctr + 128, 1u, __ATOMIC_RELAXED, __HIP_MEMORY_SCOPE_AGENT); } }
        }
    } PH_END
    SEAM(3);
    PH_BEGIN(4) {
#define WG_SEAM() do { asm volatile("s_waitcnt vmcnt(0)" ::: "memory"); __syncthreads(); if (threadIdx.x == 0) __builtin_amdgcn_fence(__ATOMIC_ACQUIRE, "agent"); __syncthreads(); } while (0)
        if (blockIdx.x < MP / 256) {
            const int pm0_ = blockIdx.x;
#define PM_OPAQUE() int pm = pm0_; asm volatile("" : "+s"(pm));
            {
                PM_OPAQUE()
                pg8::Gemm g{(const bf16_t*)(ws + WS_R1), (const bf16_t*)(ws + WS_WOUT), MP, DM, DM, DM}; pg8::RowOrder S{pm, DM / 256};
                pg8::EpiRes E{P.in[0], P.in[1], P.out + O_Y, (bf16_t*)(ws + WS_R2), (float*)(ws + WS_SSQ)};
                pg8::gemm_phase<pg8::EpiRes, pg8::RowOrder, true, true>(lds, g, S, E);
            }
            WG_SEAM();
            {
                PM_OPAQUE()
                pg8::Gemm g{(const bf16_t*)(ws + WS_R2), (const bf16_t*)(ws + WS_WMQ), MP, 512, DM, DM}; pg8::RowOrder S{pm, 2};
                pg8::EpiScale<0> E{(bf16_t*)(ws + WS_QM), 512, (const float*)(ws + WS_SSQ), QSCALE_M};
                pg8::gemm_phase<pg8::EpiScale<0>, pg8::RowOrder, true, true>(lds, g, S, E);
            }
            WG_SEAM();
            for (int hd = 0; hd < 4; ++hd) {
                PM_OPAQUE()
                const int seq = pm >> 5; const size_t row0 = (size_t)pm * 256 + 32 * wave, row = row0 + r;
                bf16_t* qp = (bf16_t*)(ws + WS_QM);
                attn_unit<false>(lds, qp + row * 512 + hd * 128, (const bf16_t*)(ws + WS_KM) + (size_t)seq * NMEM * 512 + hd * 128, (const bf16_t*)(ws + WS_VM) + (size_t)seq * NMEM * 512 + hd * 128,
                                 4, NMEM, false, 3, qp + row0 * 512 + hd * 128, 512, 0.f, nullptr);
            }
            WG_SEAM();
            {
                PM_OPAQUE()
                pg8::Gemm g{(const bf16_t*)(ws + WS_QM), (const bf16_t*)(ws + WS_WMO), MP, DM, 512, 512}; pg8::RowOrder S{pm, DM / 256};
                pg8::EpiRes E{P.out + O_Y, P.out + O_Y + (size_t)MP * DM, P.out + O_Y, (bf16_t*)(ws + WS_R2), (float*)(ws + WS_SSQ)};
                pg8::gemm_phase<pg8::EpiRes, pg8::RowOrder, true, true>(lds, g, S, E);
            }
            WG_SEAM();
        }
#undef PM_OPAQUE
#undef WG_SEAM
    } PH_END
    SEAM(4);
    PH_BEGIN(5) {
        pg8::Gemm g{(const bf16_t*)(ws + WS_R2), (const bf16_t*)(ws + WS_WUP), MP, DFF, DM, DM}; pg8::StaticOrder S; S.init(MP, DFF, G, (int)blockIdx.x);
        pg8::EpiScale<1> E{(bf16_t*)(ws + WS_H), DFF, (const float*)(ws + WS_SSQ), 1.0f};
        pg8::gemm_phase<pg8::EpiScale<1>, pg8::StaticOrder, true, true>(lds, g, S, E);
    } PH_END
    SEAM(5);
    PH_BEGIN(6) {
        pg8::Gemm g{(const bf16_t*)(ws + WS_H), (const bf16_t*)(ws + WS_WDN), MP, DM, DFF, DFF}; pg8::StaticOrder S; S.init(MP, DM, G, (int)blockIdx.x);
        pg8::EpiRes E{P.out + O_Y, P.out + O_Y + (size_t)MP * DM, P.out + O_Y, nullptr, nullptr};
        pg8::gemm_phase<pg8::EpiRes, pg8::StaticOrder, true, true>(lds, g, S, E);
    } PH_END
    SEAM(6);
    PH_BEGIN(7) {
        const float* gf = P.in[26];
        f32x4 gn[4];
#pragma unroll
        for (int j = 0; j < 4; ++j) gn[j] = ((const f32x4*)gf)[64 * j + lane];
        for (int m = blockIdx.x * 8 + wave; m < MP; m += G * 8) {
            f32x4* yp = (f32x4*)(P.out + O_Y + (size_t)m * DM);
            f32x4 v[4]; float ss = 0.f;
#pragma unroll
            for (int j = 0; j < 4; ++j) { v[j] = yp[64 * j + lane]; ss += (v[j][0] * v[j][0] + v[j][1] * v[j][1]) + (v[j][2] * v[j][2] + v[j][3] * v[j][3]); }
            const float rstd = 1.0f / sqrtf(wave_sum(ss) * (1.0f / DM) + EPS);
#pragma unroll
            for (int j = 0; j < 4; ++j) yp[64 * j + lane] = v[j] * rstd * gn[j];
        }
    } PH_END
#undef IN
#undef SEAM
}

extern "C" void kernel_launch(void* const* d_in, const int* in_sizes, int n_in, void* d_out, int out_size, void* d_ws, size_t ws_size, hipStream_t stream) {
    static int grid = 0;
    if (grid == 0) {
        if (n_in != 27 || (size_t)out_size != O_END || ws_size < WS_END || ws_size < WS_H + (size_t)MT * DFF * 2) {
            fprintf(stderr, "kernel_launch: unexpected shapes (n_in %d out %d ws %zu)\n", n_in, out_size, ws_size); grid = -1; return; }
        int dev = 0, cus = 0, per_cu = 0;
        hipGetDevice(&dev); hipDeviceGetAttribute(&cus, hipDeviceAttributeMultiprocessorCount, dev);
        hipFuncSetAttribute((const void*)mk_fwd, hipFuncAttributeMaxDynamicSharedMemorySize, LDS_BYTES);
        if (hipOccupancyMaxActiveBlocksPerMultiprocessor(&per_cu, (const void*)mk_fwd, 512, LDS_BYTES) != hipSuccess || per_cu < 1) per_cu = 1;
        (void)hipGetLastError();
        grid = cus * 1;
        if (grid < 256) { fprintf(stderr, "kernel_launch: this kernel needs 256 co-resident workgroups (one per CU), device has %d CUs\n", cus); grid = -1; return; }
    }
    if (grid < 0) return;
    (void)hipMemsetAsync((unsigned char*)d_ws + WS_BAR, 0, 256, stream);
    Params p{};
    for (int i = 0; i < 27; ++i) p.in[i] = (const float*)d_in[i];
    p.out = (float*)d_out; p.ws = (unsigned char*)d_ws; p.sub = 3;
#if MK_SINGLE
    p.ph_lo = 0; p.ph_hi = N_PHASES;
    void* args[] = {&p};
    hipError_t e = hipLaunchCooperativeKernel((const void*)mk_fwd, dim3(grid), dim3(512), args, LDS_BYTES, stream);
    if (e != hipSuccess) fprintf(stderr, "cooperative launch failed: %s (grid %d)\n", hipGetErrorString(e), grid);
#else
    for (int k = 0; k < N_PHASES; ++k) {
        p.ph_lo = k; p.ph_hi = k + 1;
#if defined(MK_SUBREP)
        if (k == 3) {
            for (int sb = 1; sb <= 2; ++sb) for (int rep = 0; rep < (sb == MK_SUBREP ? 2 : 1); ++rep) {
                (void)hipMemsetAsync((unsigned char*)d_ws + WS_CTR, 0, 512, stream);
                p.sub = sb; hipLaunchKernelGGL(mk_fwd, dim3(grid), dim3(512), LDS_BYTES, stream, p); }
            p.sub = 3; continue;
        }
#endif
        for (int rep = 0; rep < (k == MK_REP ? 2 : 1); ++rep) {
            if (rep) (void)hipMemsetAsync((unsigned char*)d_ws + WS_CTR, 0, 512, stream);
            hipLaunchKernelGGL(mk_fwd, dim3(grid), dim3(512), LDS_BYTES, stream, p);
        }
    }
#endif
}
```

```cpp
#include <hip/hip_runtime.h>
#include <hip/hip_cooperative_groups.h>
#include <cstdio>
#include <cstdint>
namespace cg = cooperative_groups;

#ifndef MK_SINGLE
#define MK_SINGLE 1
#endif

constexpr int DM = 1024, TP = 8192, NBP = 8, MP = NBP * TP, NBS = 16, TS = 32, MS = NBS * TS, MT = MP + MS;
constexpr int PAST = 1024, SKV = PAST + TS, NMEM = 256;
constexpr int DIN = 3592, NIN = 3584, DFF = 4096;
constexpr int NCHUNK_P = NBP * (TP / 64);
constexpr int NUNIT_CH = NCHUNK_P * 4 + NBS * 4;
constexpr int KROWS = MP + NBS * SKV;
constexpr float EPS = 1e-6f;
constexpr float QSCALE_D = 0.18033688011112042f;
constexpr float QSCALE_M = 0.12751743082459868f;

constexpr size_t O_Y = 0;
constexpr size_t O_PSTATE = (size_t)MT * DM;
constexpr size_t O_PCONV = O_PSTATE + (size_t)NBP * 4 * 128 * 128;
constexpr size_t O_PK = O_PCONV + (size_t)NBP * 3 * 1536;
constexpr size_t O_PV = O_PK + (size_t)MP * 512;
constexpr size_t O_PMK = O_PV + (size_t)MP * 512;
constexpr size_t O_PMV = O_PMK + (size_t)NBP * NMEM * 512;
constexpr size_t O_SSTATE = O_PMV + (size_t)NBP * NMEM * 512;
constexpr size_t O_SCONV = O_SSTATE + (size_t)NBS * 4 * 128 * 128;
constexpr size_t O_SK = O_SCONV + (size_t)NBS * 3 * 1536;
constexpr size_t O_SV = O_SK + (size_t)MS * 512;
constexpr size_t O_END = O_SV + (size_t)MS * 512;
static_assert(O_END == 139046912, "d_out size");

constexpr size_t MiB = 1u << 20;
constexpr size_t WS_WIN = 0;
constexpr size_t WS_WOUT = 7 * MiB;
constexpr size_t WS_WMQ = 9 * MiB;
constexpr size_t WS_WMKV = 10 * MiB;
constexpr size_t WS_WMO = 12 * MiB;
constexpr size_t WS_WUP = 13 * MiB;
constexpr size_t WS_WDN = 21 * MiB;
constexpr size_t WS_MH = 29 * MiB;
constexpr size_t WS_KM = 33 * MiB;
constexpr size_t WS_VM = 39 * MiB;
constexpr size_t WS_ROPE = 45 * MiB;
constexpr size_t WS_GG = 46 * MiB;
constexpr size_t WS_GB = 48 * MiB;
constexpr size_t WS_SSQ = 50 * MiB;
constexpr size_t WS_GL = 55 * MiB;
constexpr size_t WS_CTR = 55 * MiB + 65536;
constexpr size_t WS_BAR = 55 * MiB + 131072;
constexpr size_t WS_R1 = 56 * MiB;
constexpr size_t WS_R2 = 185 * MiB;
constexpr size_t WS_Z = WS_R2;
constexpr size_t WS_QD = WS_R2 + (size_t)MT * 512 * 2;
constexpr size_t WS_R3 = 314 * MiB;
constexpr size_t WS_QKVPRE = WS_R3;
constexpr size_t WS_KB = WS_QKVPRE + (size_t)MT * 1536 * 2;
constexpr size_t WS_VB = WS_KB + (size_t)KROWS * 512 * 2;
constexpr size_t CH_BYTES = 73728;
constexpr size_t WS_CH = WS_VB + (size_t)KROWS * 512 * 2;
constexpr size_t WS_END = WS_CH + (size_t)NUNIT_CH * CH_BYTES;
constexpr size_t WS_XBS = 962 * MiB, WS_QMS = 963 * MiB, WS_HS = 964 * MiB;
static_assert(WS_END <= WS_XBS && WS_HS + (size_t)MS * DFF * 2 <= 1024 * MiB, "ws map sample tail");
constexpr size_t WS_QM = 832 * MiB;
constexpr size_t WS_H = WS_R3;
static_assert(WS_QM >= WS_H + (size_t)MP * DFF * 2 && WS_QM + (size_t)MP * 512 * 2 <= WS_XBS, "ws map QM");
static_assert(WS_END <= 1024 * MiB, "ws map");
static_assert(WS_H + (size_t)MT * DFF * 2 <= 1024 * MiB, "ws map H");
static_assert(WS_R1 + (size_t)MT * DM * 2 <= WS_R2 && WS_R2 + (size_t)MT * DM * 2 <= WS_R3, "ws map R1/R2");

constexpr int LDS_BYTES = 147456;

#define LAS __attribute__((address_space(3)))
typedef unsigned short bf16_t;
typedef short bf16x8 __attribute__((ext_vector_type(8)));
typedef short s16x4 __attribute__((ext_vector_type(4)));
typedef float f32x4 __attribute__((ext_vector_type(4)));
typedef float f32x2 __attribute__((ext_vector_type(2)));
typedef float f32x16 __attribute__((ext_vector_type(16)));
typedef unsigned u32x4 __attribute__((ext_vector_type(4)));
typedef unsigned u32x2 __attribute__((ext_vector_type(2)));
typedef __bf16 bf16x2_t __attribute__((ext_vector_type(2)));

__device__ __forceinline__ unsigned pk2(float lo, float hi) { f32x2 v = {lo, hi}; bf16x2_t b = __builtin_convertvector(v, bf16x2_t); return __builtin_bit_cast(unsigned, b); }
__device__ __forceinline__ float bf_lo(unsigned u) { return __uint_as_float(u << 16); }
__device__ __forceinline__ float bf_hi(unsigned u) { return __uint_as_float(u & 0xffff0000u); }
__device__ __forceinline__ bf16_t f2bf(float f) { return (bf16_t)(pk2(f, 0.f) & 0xffffu); }
template <int M> __device__ __forceinline__ float swz_xor(float v) { static_assert(M > 0 && M < 32, "swizzle xor mask"); return __builtin_bit_cast(float, __builtin_amdgcn_ds_swizzle(__builtin_bit_cast(int, v), (M << 10) | 0x1F)); }
__device__ __forceinline__ float half_sum(float v) { const unsigned u = __builtin_bit_cast(unsigned, v); auto rr = __builtin_amdgcn_permlane32_swap(u, u, false, false); return __builtin_bit_cast(float, (unsigned)rr[0]) + __builtin_bit_cast(float, (unsigned)rr[1]); }
__device__ __forceinline__ float half_max(float v) { const unsigned u = __builtin_bit_cast(unsigned, v); auto rr = __builtin_amdgcn_permlane32_swap(u, u, false, false); return fmaxf(__builtin_bit_cast(float, (unsigned)rr[0]), __builtin_bit_cast(float, (unsigned)rr[1])); }
__device__ __forceinline__ float wave_sum(float v) {
    v += swz_xor<1>(v); v += swz_xor<2>(v); v += swz_xor<4>(v); v += swz_xor<8>(v); v += swz_xor<16>(v);
    return half_sum(v);
}
__device__ __forceinline__ int crow(int reg, int h) { return (reg & 3) + 8 * (reg >> 2) + 4 * h; }
#define MFMA32(a, b, c) __builtin_amdgcn_mfma_f32_32x32x16_bf16((a), (b), (c), 0, 0, 0)
__device__ __forceinline__ int fragpos(int row, int col, int C) {
    const int frag = (row >> 5) * (C >> 4) + (col >> 4), e = col & 15;
    return ((frag * 64 + (row & 31) + 32 * ((e >> 2) & 1)) << 3) + ((e >> 3) << 2) + (e & 3);
}
__device__ __forceinline__ bf16x8 pack8(const f32x16& x, int s8) {
    u32x4 p; p.x = pk2(x[s8], x[s8 + 1]); p.y = pk2(x[s8 + 2], x[s8 + 3]); p.z = pk2(x[s8 + 4], x[s8 + 5]); p.w = pk2(x[s8 + 6], x[s8 + 7]);
    return __builtin_bit_cast(bf16x8, p);
}

__device__ __forceinline__ s16x4 vtr(const LAS unsigned char* p) { typedef short v4i16_t __attribute__((ext_vector_type(4))); return __builtin_bit_cast(s16x4, __builtin_amdgcn_ds_read_tr16_b64_v4i16((LAS v4i16_t*)p)); }

struct Params {
    const float* in[27];
    float* out;
    unsigned char* ws;
    int ph_lo, ph_hi, sub, pad;
};
namespace pg8 {
#define PG8_LAS __attribute__((address_space(3)))
typedef unsigned short bf16_t;
typedef short bf16x8 __attribute__((ext_vector_type(8)));
typedef float f32x4 __attribute__((ext_vector_type(4)));
typedef unsigned u32x4 __attribute__((ext_vector_type(4)));
constexpr int BM = 256, BK = 64, HALF = 128, HTB = HALF * BK * 2  , STAGE_BYTES = 8 * HTB, NXCD = 8, WGM = 8;

__host__ __device__ __forceinline__ int lds_byte(int r, int c) { const int st = (r >> 4) * 2 + (c >> 5), rr = r & 15, cc = c & 31, ob = rr * 64 + cc * 2; return st * 1024 + (ob ^ (((ob >> 9) & 1) << 5)); }
__host__ __device__ __forceinline__ void stage_rc(int b, int& R, int& C) { const int st = b / 1024, sb = b % 1024, swz = sb ^ (((sb >> 9) & 1) << 5); R = (st >> 1) * 16 + swz / 64; C = (st & 1) * 32 + (swz % 64) / 2; }
__host__ __device__ __forceinline__ int perm32(int rho) { const int n = rho >> 4, i = rho & 15; return 8 * (i >> 2) + 4 * n + (i & 3); }

struct Unit { int pm, pn, ko; };
struct Gemm { const bf16_t* A; const bf16_t* Bt; int M, N, K, Kn; };

struct StaticOrder {
    int nM, nN, nwg, G, c;
    __host__ __device__ void init(int M, int N, int G_, int c_) { nM = M / BM; nN = N / BM; nwg = nM * nN; G = G_; c = c_; }
    __host__ __device__ bool next(int i, Unit& u) const {
        const long L = (long)i * G + c; if (L >= nwg) return false;
        int wgid = (int)L; { const int q = nwg / NXCD, r = nwg % NXCD, xcd = wgid % NXCD, off = wgid / NXCD; wgid = (xcd < r ? xcd * (q + 1) : r * (q + 1) + (xcd - r) * q) + off; }
        const int nig = WGM * nN, gid = wgid / nig, fm = gid * WGM, gsz = (nM - fm) < WGM ? (nM - fm) : WGM;
        u.pm = fm + ((wgid % nig) % gsz); u.pn = (wgid % nig) / gsz; u.ko = 0; return true;
    }
    __device__ __forceinline__ void a_ready(const Unit&) const {}
    __device__ __forceinline__ void done(const Unit&) const {}
};

__device__ __forceinline__ unsigned cvt_pk_bf16(float lo, float hi) { unsigned r; asm volatile("v_cvt_pk_bf16_f32 %0, %1, %2" : "=v"(r) : "v"(lo), "v"(hi)); return r; }
}
namespace pg8 {
template <class Epi, class Sched, bool ALIGN_EPI = false, bool SP2 = false>
__device__ __forceinline__ void gemm_phase(PG8_LAS unsigned char* lds, const Gemm g, const Sched& S, const Epi& E) {
    int tid = threadIdx.x; asm volatile("" : "+v"(tid));
    const int wid = __builtin_amdgcn_readfirstlane(tid >> 6), lane = tid & 63, wr = wid >> 2, wc = wid & 3, fr = lane & 15, fq = lane >> 4;
    const int K = g.K, nt = g.Kn / BK;
    unsigned voffA[2], voffB[2];
#pragma unroll
    for (int i = 0; i < 2; ++i) { int R, C; stage_rc(tid * 16 + i * 8192, R, C); const int Rb = Epi::PERM ? ((R & ~31) + perm32(R & 31)) : R;
        voffA[i] = (unsigned)(R * K + C) * 2u; voffB[i] = (unsigned)(Rb * K + C) * 2u; }
    const size_t kstep = (size_t)(BK * 2);
    const size_t hstep = (size_t)HALF * K * 2;
    const size_t tstep = 2 * hstep;
    const unsigned ldsw = (unsigned)wid * 1024u;
    const int aoff = lds_byte(wr * 64 + fr, fq * 8), boff = lds_byte(wc * 32 + fr, fq * 8);
#define PG8_SA(b, h) (((b) * 2 + (h)) * HTB)
#define PG8_SB(b, h) ((4 + (b) * 2 + (h)) * HTB)
#define PG8_STAGE(bufoff, gbase, voff) do { _Pragma("unroll") for (int _i = 0; _i < 2; ++_i) \
        __builtin_amdgcn_global_load_lds((const unsigned*)((const char*)(gbase) + (voff)[_i]), (PG8_LAS unsigned*)(lds + (bufoff) + ldsw + _i * 8192), 16, 0, 0); } while (0)
#define PG8_LDA(dst, b, h) do { _Pragma("unroll") for (int m = 0; m < 4; ++m) _Pragma("unroll") for (int k = 0; k < 2; ++k) dst[m][k] = *(const PG8_LAS bf16x8*)(lds + PG8_SA(b, h) + aoff + m * 2048 + k * 1024); } while (0)
#define PG8_LDB(dst, b, h) do { _Pragma("unroll") for (int n = 0; n < 2; ++n) _Pragma("unroll") for (int k = 0; k < 2; ++k) dst[n][k] = *(const PG8_LAS bf16x8*)(lds + PG8_SB(b, h) + boff + n * 2048 + k * 1024); } while (0)
#define PG8_MMA(ai, bj, At, Bt) do { __builtin_amdgcn_s_setprio(1); _Pragma("unroll") for (int m = 0; m < 4; ++m) _Pragma("unroll") for (int n = 0; n < 2; ++n) _Pragma("unroll") for (int k = 0; k < 2; ++k) \
        acc[ai][bj][m][n] = __builtin_amdgcn_mfma_f32_16x16x32_bf16(Bt[n][k], At[m][k], acc[ai][bj][m][n], 0, 0, 0); __builtin_amdgcn_s_setprio(0); } while (0)
#define PG8_WAIT_V(n) asm volatile("s_waitcnt vmcnt(" #n ")" ::: "memory")
#define PG8_WAIT_L(n) asm volatile("s_waitcnt lgkmcnt(" #n ")" ::: "memory")
#define PG8_BAR __builtin_amdgcn_s_barrier()
#define PG8_SCHED __builtin_amdgcn_sched_barrier(0)
    Unit cur, nxt; int ui = 0;
    if (!S.next(0, cur)) return;
    f32x4 acc[2][2][4][2];
#pragma unroll
    for (int a = 0; a < 2; ++a)
#pragma unroll
        for (int b = 0; b < 2; ++b)
#pragma unroll
            for (int m = 0; m < 4; ++m)
#pragma unroll
                for (int n = 0; n < 2; ++n) acc[a][b][m][n] = (f32x4){0.f, 0.f, 0.f, 0.f};
    bf16x8 At[4][2], B0[2][2], B1[2][2];
    const char* cA = (const char*)g.A + (size_t)cur.pm * tstep + (size_t)cur.ko * 2; const char* cB = (const char*)g.Bt + (size_t)cur.pn * tstep + (size_t)cur.ko * 2;
    S.a_ready(cur);
    if constexpr (SP2) {
        PG8_STAGE(PG8_SB(0, 0), cB, voffB); PG8_STAGE(PG8_SB(0, 1), cB + hstep, voffB); PG8_STAGE(PG8_SA(0, 0), cA, voffA); PG8_STAGE(PG8_SA(0, 1), cA + hstep, voffA);
        if (wr == 1) PG8_BAR;
        PG8_WAIT_V(2); PG8_BAR;
        PG8_STAGE(PG8_SB(1, 0), cB + kstep, voffB); PG8_STAGE(PG8_SA(1, 0), cA + kstep, voffA); PG8_STAGE(PG8_SB(1, 1), cB + hstep + kstep, voffB);
        PG8_WAIT_V(6); PG8_BAR;
    } else {
        PG8_STAGE(PG8_SB(0, 0), cB, voffB); PG8_STAGE(PG8_SA(0, 0), cA, voffA); PG8_STAGE(PG8_SB(0, 1), cB + hstep, voffB); PG8_STAGE(PG8_SA(0, 1), cA + hstep, voffA);
        if (wr == 1) PG8_BAR;
        PG8_WAIT_V(4); PG8_BAR;
        PG8_STAGE(PG8_SB(1, 0), cB + kstep, voffB); PG8_STAGE(PG8_SA(1, 0), cA + kstep, voffA); PG8_STAGE(PG8_SB(1, 1), cB + hstep + kstep, voffB);
        PG8_WAIT_V(6); PG8_BAR;
    }
    for (;;) {
        const bool has_next = S.next(ui + 1, nxt);
        const char* nA = has_next ? (const char*)g.A + (size_t)nxt.pm * tstep + (size_t)nxt.ko * 2 : cA; const char* nB = has_next ? (const char*)g.Bt + (size_t)nxt.pn * tstep + (size_t)nxt.ko * 2 : cB;
        for (int t = 0; t < nt; t += 2) {
            const bool last = (t == nt - 2);
            const char* a1 = cA + (size_t)(t + 1) * kstep;
            const char* a2 = last ? nA : cA + (size_t)(t + 2) * kstep; const char* b2 = last ? nB : cB + (size_t)(t + 2) * kstep;
            const char* a3 = a2 + kstep; const char* b3 = b2 + kstep;
            if (last && has_next) S.a_ready(nxt);
            if constexpr (SP2) {
            PG8_LDB(B0, 0, 0); PG8_LDB(B1, 0, 1); PG8_SCHED; PG8_LDA(At, 0, 0); PG8_STAGE(PG8_SA(1, 1), a1 + hstep, voffA);
            PG8_WAIT_V(8); PG8_WAIT_L(0); PG8_BAR; PG8_MMA(0, 0, At, B0); PG8_MMA(0, 1, At, B1); PG8_BAR; PG8_SCHED;
            PG8_LDA(At, 0, 1); PG8_STAGE(PG8_SB(0, 0), b2, voffB); PG8_STAGE(PG8_SB(0, 1), b2 + hstep, voffB); PG8_STAGE(PG8_SA(0, 0), a2, voffA);
            PG8_WAIT_V(8); PG8_WAIT_L(0); PG8_BAR; PG8_MMA(1, 0, At, B0); PG8_MMA(1, 1, At, B1); PG8_BAR; PG8_SCHED;
            PG8_LDB(B0, 1, 0); PG8_LDB(B1, 1, 1); PG8_SCHED; PG8_LDA(At, 1, 0); PG8_STAGE(PG8_SA(0, 1), a2 + hstep, voffA);
            PG8_WAIT_V(8); PG8_WAIT_L(0); PG8_BAR; PG8_MMA(0, 0, At, B0); PG8_MMA(0, 1, At, B1); PG8_BAR; PG8_SCHED;
            PG8_LDA(At, 1, 1); PG8_STAGE(PG8_SB(1, 0), b3, voffB); PG8_STAGE(PG8_SB(1, 1), b3 + hstep, voffB); PG8_STAGE(PG8_SA(1, 0), a3, voffA);
            PG8_WAIT_V(8); PG8_WAIT_L(0); PG8_BAR; PG8_MMA(1, 0, At, B0); PG8_MMA(1, 1, At, B1); PG8_BAR; PG8_SCHED;
            } else {
            PG8_LDB(B0, 0, 0); PG8_SCHED; PG8_LDA(At, 0, 0); PG8_STAGE(PG8_SA(1, 1), a1 + hstep, voffA);
            PG8_WAIT_L(8); PG8_BAR; PG8_WAIT_L(0); PG8_MMA(0, 0, At, B0); PG8_BAR; PG8_SCHED;
            PG8_LDB(B1, 0, 1); PG8_STAGE(PG8_SB(0, 0), b2, voffB);
            PG8_BAR; PG8_WAIT_L(0); PG8_MMA(0, 1, At, B1); PG8_BAR;
            PG8_LDA(At, 0, 1); PG8_STAGE(PG8_SA(0, 0), a2, voffA);
            PG8_BAR; PG8_WAIT_L(0); PG8_MMA(1, 0, At, B0); PG8_BAR; PG8_SCHED;
            PG8_STAGE(PG8_SB(0, 1), b2 + hstep, voffB);
            PG8_WAIT_V(6); PG8_BAR; PG8_MMA(1, 1, At, B1); PG8_BAR;
            PG8_LDB(B0, 1, 0); PG8_SCHED; PG8_LDA(At, 1, 0); PG8_STAGE(PG8_SA(0, 1), a2 + hstep, voffA);
            PG8_WAIT_L(8); PG8_BAR; PG8_WAIT_L(0); PG8_MMA(0, 0, At, B0); PG8_BAR; PG8_SCHED;
            PG8_LDB(B1, 1, 1); PG8_STAGE(PG8_SB(1, 0), b3, voffB);
            PG8_BAR; PG8_WAIT_L(0); PG8_MMA(0, 1, At, B1); PG8_BAR;
            PG8_LDA(At, 1, 1); PG8_STAGE(PG8_SA(1, 0), a3, voffA);
            PG8_BAR; PG8_WAIT_L(0); PG8_MMA(1, 0, At, B0); PG8_BAR; PG8_SCHED;
            PG8_STAGE(PG8_SB(1, 1), b3 + hstep, voffB);
            PG8_WAIT_V(6); PG8_BAR; PG8_MMA(1, 1, At, B1); PG8_BAR;
            }
        }
        if constexpr (ALIGN_EPI) { if (wr == 0) PG8_BAR; }
        if constexpr (!Epi::AFTER_DRAIN) { E(acc, cur, wr, wc, fr, fq); S.done(cur); }
        if (!has_next) break;
#pragma unroll
        for (int a = 0; a < 2; ++a)
#pragma unroll
            for (int b = 0; b < 2; ++b)
#pragma unroll
                for (int m = 0; m < 4; ++m)
#pragma unroll
                    for (int n = 0; n < 2; ++n) acc[a][b][m][n] = (f32x4){0.f, 0.f, 0.f, 0.f};
        cur = nxt; cA = nA; cB = nB; ++ui;
        if constexpr (ALIGN_EPI) { if (wr == 1) PG8_BAR; }
    }
    PG8_WAIT_V(0);
    if constexpr (!ALIGN_EPI) { if (wr == 0) PG8_BAR; }
    PG8_BAR;
    if constexpr (Epi::AFTER_DRAIN) { E.fused(acc, cur, wr, wc, fr, fq, lds, wid, lane); S.done(cur); }
#undef PG8_SA
#undef PG8_SB
#undef PG8_STAGE
#undef PG8_LDA
#undef PG8_LDB
#undef PG8_MMA
#undef PG8_WAIT_V
#undef PG8_WAIT_L
#undef PG8_BAR
#undef PG8_SCHED
}
}
namespace pg8 {
__device__ __forceinline__ u32x4 pack8f(const f32x4& a, const f32x4& b) { u32x4 w; w.x = ::pk2(a[0], a[1]); w.y = ::pk2(a[2], a[3]); w.z = ::pk2(b[0], b[1]); w.w = ::pk2(b[2], b[3]); return w; }

struct EpiIn {
    static constexpr bool PERM = true, AFTER_DRAIN = false;
    bf16_t *qkvpre, *z, *qd, *kb, *vb; float* out; const float* rope;
#define EPI_ROWS(ai, m) const int row = u.pm * BM + (ai) * HALF + wr * 64 + (m) * 16 + fr; const bool smp = row >= MP; const int rs = row - MP; \
        const int t = smp ? (rs & 31) : (row & (TP - 1)); const int sq = smp ? (rs >> 5) : (row >> 13);
    __device__ __forceinline__ void operator()(const f32x4 (&acc)[2][2][4][2], const Unit& u, int wr, int wc, int fr, int fq) const {
        const int pn = u.pn, cl = wc * 32 + 8 * fq;
        if (pn < 6) {
#pragma unroll
            for (int ai = 0; ai < 2; ++ai)
#pragma unroll
                for (int m = 0; m < 4; ++m) { EPI_ROWS(ai, m)
                    const int tl = smp ? t - (TS - 3) : t - (TP - 3);
#pragma unroll
                    for (int bj = 0; bj < 2; ++bj) { const int c = pn * BM + bj * HALF + cl; const f32x4 v0 = acc[ai][bj][m][0], v1 = acc[ai][bj][m][1];
                        *(u32x4*)(qkvpre + (size_t)row * 1536 + c) = pack8f(v0, v1);
                        if (tl >= 0) { float* o = out + (smp ? O_SCONV : O_PCONV) + (size_t)(sq * 3 + tl) * 1536 + c; *(f32x4*)o = v0; *(f32x4*)(o + 4) = v1; } }
                    asm volatile("" ::: "memory"); }
        } else if (pn < 8) {
#pragma unroll
            for (int ai = 0; ai < 2; ++ai)
#pragma unroll
                for (int m = 0; m < 4; ++m) { const int row = u.pm * BM + ai * HALF + wr * 64 + m * 16 + fr;
#pragma unroll
                    for (int bj = 0; bj < 2; ++bj) { const int c = (pn - 6) * BM + bj * HALF + cl; *(u32x4*)(z + (size_t)row * 512 + c) = pack8f(acc[ai][bj][m][0], acc[ai][bj][m][1]); }
                    asm volatile("" ::: "memory"); }
        } else if (pn < 12) {
            const bool isq = pn < 10;
#pragma unroll
            for (int ai = 0; ai < 2; ++ai)
#pragma unroll
                for (int m = 0; m < 4; ++m) { EPI_ROWS(ai, m)
                    const int pos = smp ? PAST + t : t;
                    const float* rp = rope + (size_t)pos * 16;
                    const size_t kr = smp ? (size_t)MP + (size_t)sq * SKV + PAST + t : (size_t)row;
#pragma unroll
                    for (int bj = 0; bj < 2; ++bj) { const int cc = (pn & 1) * BM + bj * HALF + cl; f32x4 v0 = acc[ai][bj][m][0], v1 = acc[ai][bj][m][1];
                        if ((wc & 1) == 0) {
                            f32x4 p0, p1;
#pragma unroll
                            for (int e = 0; e < 4; ++e) { p0[e] = ::swz_xor<16>(v0[e]); p1[e] = ::swz_xor<16>(v1[e]); }
                            if (fq < 2) {
                                const f32x4 c0 = *(const f32x4*)(rp), c1 = *(const f32x4*)(rp + 4), s0 = *(const f32x4*)(rp + 8), s1 = *(const f32x4*)(rp + 12);
                                const float sg = fq == 0 ? -1.f : 1.f;
                                v0 = v0 * c0 + (p0 * s0) * sg; v1 = v1 * c1 + (p1 * s1) * sg;
                            }
                        }
                        if (isq) { *(u32x4*)(qd + (size_t)row * 512 + cc) = pack8f(v0 * QSCALE_D, v1 * QSCALE_D); }
                        else { float* o = out + (smp ? O_SK + (size_t)rs * 512 : O_PK + (size_t)row * 512) + cc; *(f32x4*)o = v0; *(f32x4*)(o + 4) = v1;
                               *(u32x4*)(kb + kr * 512 + cc) = pack8f(v0, v1); } }
                    asm volatile("" ::: "memory"); }
        } else {
#pragma unroll
            for (int ai = 0; ai < 2; ++ai)
#pragma unroll
                for (int m = 0; m < 4; ++m) { EPI_ROWS(ai, m)
                    const size_t kr = smp ? (size_t)MP + (size_t)sq * SKV + PAST + t : (size_t)row;
#pragma unroll
                    for (int bj = 0; bj < 2; ++bj) { const int cc = (pn & 1) * BM + bj * HALF + cl; const f32x4 v0 = acc[ai][bj][m][0], v1 = acc[ai][bj][m][1];
                        float* o = out + (smp ? O_SV + (size_t)rs * 512 : O_PV + (size_t)row * 512) + cc; *(f32x4*)o = v0; *(f32x4*)(o + 4) = v1;
                        *(u32x4*)(vb + kr * 512 + cc) = pack8f(v0, v1); }
                    asm volatile("" ::: "memory"); }
        }
    }
#undef EPI_ROWS
};
struct EpiMem {
    static constexpr bool PERM = true, AFTER_DRAIN = false;
    bf16_t *km, *vm; float* out;
    __device__ __forceinline__ void operator()(const f32x4 (&acc)[2][2][4][2], const Unit& u, int wr, int wc, int fr, int fq) const {
        const int pn = u.pn, cl = wc * 32 + 8 * fq;
#pragma unroll
        for (int ai = 0; ai < 2; ++ai)
#pragma unroll
            for (int m = 0; m < 4; ++m) {
                const int row = u.pm * BM + ai * HALF + wr * 64 + m * 16 + fr;
#pragma unroll
                for (int bj = 0; bj < 2; ++bj) {
                    const int c = pn * BM + bj * HALF + cl; const int cc = c & 511;
                    const f32x4 v0 = acc[ai][bj][m][0], v1 = acc[ai][bj][m][1];
                    float* o = out + (pn < 2 ? O_PMK : O_PMV) + (size_t)row * 512 + cc; *(f32x4*)o = v0; *(f32x4*)(o + 4) = v1;
                    *(u32x4*)((pn < 2 ? km : vm) + (size_t)row * 512 + cc) = pack8f(v0, v1);
                }
            }
    }
};
struct EpiRes {
    static constexpr bool PERM = true, AFTER_DRAIN = false;
    const float *resid_p, *resid_s; float* y; bf16_t* xb; float* ssq;
    __device__ __forceinline__ void operator()(const f32x4 (&acc)[2][2][4][2], const Unit& u, int wr, int wc, int fr, int fq) const {
        const int pn = u.pn, cl = wc * 32 + 8 * fq;
#pragma unroll
        for (int ai = 0; ai < 2; ++ai)
#pragma unroll
            for (int m = 0; m < 4; ++m) {
                const int row = u.pm * BM + ai * HALF + wr * 64 + m * 16 + fr;
                const float* rp = row < MP ? resid_p + (size_t)row * DM : resid_s + (size_t)(row - MP) * DM;
                float ss = 0.f;
#pragma unroll
                for (int bj = 0; bj < 2; ++bj) {
                    const int c = pn * BM + bj * HALF + cl;
                    const f32x4 v0 = acc[ai][bj][m][0] + *(const f32x4*)(rp + c), v1 = acc[ai][bj][m][1] + *(const f32x4*)(rp + c + 4);
                    *(f32x4*)(y + (size_t)row * DM + c) = v0; *(f32x4*)(y + (size_t)row * DM + c + 4) = v1;
                    if (xb) *(u32x4*)(xb + (size_t)row * DM + c) = pack8f(v0, v1);
                    ss += (v0[0] * v0[0] + v0[1] * v0[1]) + (v0[2] * v0[2] + v0[3] * v0[3]) + (v1[0] * v1[0] + v1[1] * v1[1]) + (v1[2] * v1[2] + v1[3] * v1[3]);
                }
                ss += ::swz_xor<16>(ss); ss = ::half_sum(ss);
                if (ssq && fq == 0) ssq[(size_t)row * 16 + pn * 4 + wc] = ss;
            }
    }
};
template <int ACT> struct EpiScale {
    static constexpr bool PERM = true, AFTER_DRAIN = false;
    bf16_t* O; int ldc; const float* ssq; float scale;
    __device__ __forceinline__ void operator()(const f32x4 (&acc)[2][2][4][2], const Unit& u, int wr, int wc, int fr, int fq) const {
        const int pn = u.pn, cl = wc * 32 + 8 * fq;
#pragma unroll
        for (int ai = 0; ai < 2; ++ai)
#pragma unroll
            for (int m = 0; m < 4; ++m) {
                const int row = u.pm * BM + ai * HALF + wr * 64 + m * 16 + fr;
                const f32x4* sp = (const f32x4*)(ssq + (size_t)row * 16);
                const f32x4 a = sp[0] + sp[1] + sp[2] + sp[3];
                const float rstd = __builtin_amdgcn_rsqf(((a[0] + a[1]) + (a[2] + a[3])) * (1.0f / DM) + EPS) * scale;
#pragma unroll
                for (int bj = 0; bj < 2; ++bj) {
                    const int c = pn * BM + bj * HALF + cl;
                    f32x4 v0 = acc[ai][bj][m][0] * rstd, v1 = acc[ai][bj][m][1] * rstd;
                    if (ACT == 1) {
#pragma unroll
                        for (int e = 0; e < 4; ++e) { const float a0 = fmaxf(v0[e], 0.f), a1 = fmaxf(v1[e], 0.f); v0[e] = a0 * a0; v1[e] = a1 * a1; }
                    }
                    *(u32x4*)(O + (size_t)row * ldc + c) = pack8f(v0, v1);
                }
            }
    }
};
struct EpiAtomic {
    static constexpr bool PERM = true, AFTER_DRAIN = false;
    float* y;
    __device__ __forceinline__ void operator()(const f32x4 (&acc)[2][2][4][2], const Unit& u, int wr, int wc, int fr, int fq) const {
        const int pn = u.pn, cl = wc * 32 + 8 * fq;
#pragma unroll
        for (int ai = 0; ai < 2; ++ai)
#pragma unroll
            for (int m = 0; m < 4; ++m) {
                const int row = u.pm * BM + ai * HALF + wr * 64 + m * 16 + fr;
#pragma unroll
                for (int bj = 0; bj < 2; ++bj) {
                    float* p = y + (size_t)row * DM + pn * BM + bj * HALF + cl;
#pragma unroll
                    for (int e = 0; e < 4; ++e) { unsafeAtomicAdd(p + e, acc[ai][bj][m][0][e]); unsafeAtomicAdd(p + 4 + e, acc[ai][bj][m][1][e]); }
                }
            }
    }
};
struct SplitKOrder {
    int pm0, nN, nks, klen, ntot, G, c;
    __device__ void init(int pm0_, int npm, int nN_, int nks_, int klen_, int G_, int c_) { pm0 = pm0_; nN = nN_; nks = nks_; klen = klen_; ntot = npm * nN_ * nks_; G = G_; c = c_; }
    __device__ bool next(int i, Unit& u) const { const int L = i * G + c; if (L >= ntot) return false; const int kc = L % nks, t = L / nks; u.pn = t % nN; u.pm = pm0 + t / nN; u.ko = kc * klen; return true; }
    __device__ __forceinline__ void a_ready(const Unit&) const {}
    __device__ __forceinline__ void done(const Unit&) const {}
};
struct TeamOrder {
    int pm0, nN, ntot, G, c;
    __device__ void init(int pm0_, int npm, int nN_, int G_, int c_) { pm0 = pm0_; nN = nN_; ntot = npm * nN_; G = G_; c = c_; }
    __device__ bool next(int i, Unit& u) const { const int L = i * G + c; if (L >= ntot) return false; u.pn = L % nN; u.pm = pm0 + L / nN; u.ko = 0; return true; }
    __device__ __forceinline__ void a_ready(const Unit&) const {}
    __device__ __forceinline__ void done(const Unit&) const {}
};
struct RowOrder {
    int pm, nN;
    __device__ bool next(int i, Unit& u) const { if (i >= nN) return false; int p = pm; asm volatile("" : "+s"(p)); u.pm = p; u.pn = i; u.ko = 0; return true; }
    __device__ __forceinline__ void a_ready(const Unit&) const {}
    __device__ __forceinline__ void done(const Unit&) const {}
};
struct OneUnit {
    int pm, pn;
    __device__ bool next(int i, Unit& u) const { if (i) return false; u.pm = pm; u.pn = pn; u.ko = 0; return true; }
    __device__ __forceinline__ void a_ready(const Unit&) const {}
    __device__ __forceinline__ void done(const Unit&) const {}
};
}
__device__ __forceinline__ void p0_tr_item(const float* __restrict__ W, int ldw, int K, int c0, int nblk, bf16_t* __restrict__ WT, int row0, const float* __restrict__ gk, LAS float* scr, int item, int lane) {
    const int kb = item / nblk, nb = item % nblk, k0 = 64 * kb, n0 = 32 * nb;
#pragma unroll 8
    for (int i = 0; i < 32; ++i) { const int kk = 2 * i + (lane >> 5); float v = W[(size_t)(k0 + kk) * ldw + c0 + n0 + (lane & 31)]; if (gk) v *= gk[k0 + kk]; scr[kk * 33 + (lane & 31)] = v; }
    asm volatile("s_waitcnt lgkmcnt(0)" ::: "memory");
    const int c = lane & 7;
#pragma unroll
    for (int j = 0; j < 4; ++j) { const int n = (lane >> 3) + 8 * j; const LAS float* s = scr + (8 * c) * 33 + n;
        u32x4 o; o.x = pk2(s[0 * 33], s[1 * 33]); o.y = pk2(s[2 * 33], s[3 * 33]); o.z = pk2(s[4 * 33], s[5 * 33]); o.w = pk2(s[6 * 33], s[7 * 33]);
        *(u32x4*)(WT + (size_t)(row0 + n0 + n) * K + k0 + 8 * c) = o; }
    asm volatile("s_waitcnt lgkmcnt(0)" ::: "memory");
}
__device__ __forceinline__ void p0_prologue(const Params& P, LAS unsigned char* lds) {
    const int tid = threadIdx.x, lane = tid & 63, wave = __builtin_amdgcn_readfirstlane(tid >> 6);
    const int gw = blockIdx.x * 8 + wave, NGW = gridDim.x * 8;
    unsigned char* ws = P.ws;
    if (blockIdx.x == 0 && tid < 256) ((unsigned*)(ws + WS_CTR))[tid] = 0u;
    LAS float* wab = (LAS float*)lds;
    const float* w_in = P.in[10];
    for (int i = tid; i < 8192; i += 512) { const int k = i >> 3, c = i & 7; wab[c * 1024 + k] = w_in[(size_t)k * DIN + 2048 + c]; }
    __syncthreads();
    LAS float* scr = (LAS float*)(lds + 32768 + wave * 8448);
    {
        constexpr int I0 = 16 * 64, I1 = 16 * 48, I2 = 16 * 32, I3 = 16 * 16, I4 = 16 * 32, I5 = 8 * 32, I6 = 16 * 128, I7 = 64 * 32;
        constexpr int NIT = I0 + I1 + I2 + I3 + I4 + I5 + I6 + I7;
        for (int it = gw; it < NIT; it += NGW) {
            int r = it;
            if (r < I0) { p0_tr_item(w_in, DIN, 1024, 0, 64, (bf16_t*)(ws + WS_WIN), 0, nullptr, scr, r, lane); continue; } r -= I0;
            if (r < I1) { p0_tr_item(w_in, DIN, 1024, 2056, 48, (bf16_t*)(ws + WS_WIN), 2048, nullptr, scr, r, lane); continue; } r -= I1;
            if (r < I2) { p0_tr_item(P.in[17], 1024, 1024, 0, 32, (bf16_t*)(ws + WS_WOUT), 0, nullptr, scr, r, lane); continue; } r -= I2;
            if (r < I3) { p0_tr_item(P.in[20], 512, 1024, 0, 16, (bf16_t*)(ws + WS_WMQ), 0, P.in[18], scr, r, lane); continue; } r -= I3;
            if (r < I4) { p0_tr_item(P.in[21], 1024, 1024, 0, 32, (bf16_t*)(ws + WS_WMKV), 0, nullptr, scr, r, lane); continue; } r -= I4;
            if (r < I5) { p0_tr_item(P.in[22], 1024, 512, 0, 32, (bf16_t*)(ws + WS_WMO), 0, nullptr, scr, r, lane); continue; } r -= I5;
            if (r < I6) { p0_tr_item(P.in[24], 4096, 1024, 0, 128, (bf16_t*)(ws + WS_WUP), 0, P.in[23], scr, r, lane); continue; } r -= I6;
            p0_tr_item(P.in[25], 1024, 4096, 0, 32, (bf16_t*)(ws + WS_WDN), 0, nullptr, scr, r, lane);
        }
    }
    {
        const float* gmix = P.in[9]; bf16_t* xn = (bf16_t*)(ws + WS_R1);
        float* GG = (float*)(ws + WS_GG); float* GB = (float*)(ws + WS_GB);
        f32x4 gn[4];
#pragma unroll
        for (int j = 0; j < 4; ++j) gn[j] = ((const f32x4*)gmix)[64 * j + lane];
        for (int m0 = gw; m0 < MT; m0 += 2 * NGW) {
            const int m1 = m0 + NGW; const bool has1 = m1 < MT; const int m1c = has1 ? m1 : m0;
            const float* xr0 = m0 < MP ? P.in[0] + (size_t)m0 * DM : P.in[1] + (size_t)(m0 - MP) * DM;
            const float* xr1 = m1c < MP ? P.in[0] + (size_t)m1c * DM : P.in[1] + (size_t)(m1c - MP) * DM;
            f32x4 v0[4], v1[4]; float s0 = 0.f, s1 = 0.f;
#pragma unroll
            for (int j = 0; j < 4; ++j) { v0[j] = ((const f32x4*)xr0)[64 * j + lane]; v1[j] = ((const f32x4*)xr1)[64 * j + lane]; }
#pragma unroll
            for (int j = 0; j < 4; ++j) { s0 += (v0[j][0] * v0[j][0] + v0[j][1] * v0[j][1]) + (v0[j][2] * v0[j][2] + v0[j][3] * v0[j][3]);
                                          s1 += (v1[j][0] * v1[j][0] + v1[j][1] * v1[j][1]) + (v1[j][2] * v1[j][2] + v1[j][3] * v1[j][3]); }
            s0 = wave_sum(s0); s1 = wave_sum(s1);
            const float r0 = 1.0f / sqrtf(s0 * (1.0f / DM) + EPS), r1 = 1.0f / sqrtf(s1 * (1.0f / DM) + EPS);
            float ga0[8], ga1[8];
#pragma unroll
            for (int c = 0; c < 8; ++c) { ga0[c] = 0.f; ga1[c] = 0.f; }
#pragma unroll
            for (int j = 0; j < 4; ++j) {
                v0[j] = v0[j] * r0 * gn[j]; v1[j] = v1[j] * r1 * gn[j];
                u32x2 o; o.x = pk2(v0[j][0], v0[j][1]); o.y = pk2(v0[j][2], v0[j][3]);
                *(u32x2*)(xn + (size_t)m0 * DM + 256 * j + 4 * lane) = o;
                if (has1) { o.x = pk2(v1[j][0], v1[j][1]); o.y = pk2(v1[j][2], v1[j][3]); *(u32x2*)(xn + (size_t)m1 * DM + 256 * j + 4 * lane) = o; }
#pragma unroll
                for (int c = 0; c < 8; ++c) { const f32x4 w = *(const LAS f32x4*)(wab + c * 1024 + 256 * j + 4 * lane);
                    ga0[c] += (v0[j][0] * w[0] + v0[j][1] * w[1]) + (v0[j][2] * w[2] + v0[j][3] * w[3]);
                    ga1[c] += (v1[j][0] * w[0] + v1[j][1] * w[1]) + (v1[j][2] * w[2] + v1[j][3] * w[3]); }
            }
#pragma unroll
            for (int c = 0; c < 8; ++c) { ga0[c] = wave_sum(ga0[c]); ga1[c] = wave_sum(ga1[c]); }
            if (lane < 8) {
                const int hl = lane & 3; const bool second = lane >= 4;
                float a = second ? ga1[0] : ga0[0], b = second ? ga1[4] : ga0[4];
                if (hl == 1) { a = second ? ga1[1] : ga0[1]; b = second ? ga1[5] : ga0[5]; } else if (hl == 2) { a = second ? ga1[2] : ga0[2]; b = second ? ga1[6] : ga0[6]; } else if (hl == 3) { a = second ? ga1[3] : ga0[3]; b = second ? ga1[7] : ga0[7]; }
                const int mm = second ? m1 : m0;
                if (!second || has1) {
                    const float xx = a + P.in[13][hl];
                    const float sp = xx > 20.f ? xx : log1pf(expf(xx));
                    GG[(size_t)mm * 4 + hl] = -expf(P.in[12][hl]) * sp;
                    GB[(size_t)mm * 4 + hl] = 1.0f / (1.0f + expf(-b));
                }
            }
        }
    }
    {
        const float* gm = P.in[19]; bf16_t* mh = (bf16_t*)(ws + WS_MH);
        for (int m = gw; m < NBP * NMEM; m += NGW) {
            const float* xrow = P.in[2] + (size_t)m * DM;
            f32x4 v[4]; float ss = 0.f;
#pragma unroll
            for (int j = 0; j < 4; ++j) { v[j] = ((const f32x4*)xrow)[64 * j + lane]; ss += (v[j][0] * v[j][0] + v[j][1] * v[j][1]) + (v[j][2] * v[j][2] + v[j][3] * v[j][3]); }
            const float rstd = 1.0f / sqrtf(wave_sum(ss) * (1.0f / DM) + EPS);
#pragma unroll
            for (int j = 0; j < 4; ++j) { const f32x4 g = ((const f32x4*)gm)[64 * j + lane]; const f32x4 o4 = v[j] * rstd * g;
                u32x2 o; o.x = pk2(o4[0], o4[1]); o.y = pk2(o4[2], o4[3]); *(u32x2*)(mh + (size_t)m * DM + 256 * j + 4 * lane) = o; }
        }
    }
    {
        constexpr int R0 = NBS * PAST, R1 = NBS * NMEM;
        for (int it = gw; it < 2 * R0 + 2 * R1; it += NGW) {
            int r = it; const float* src; bf16_t* dst;
            if (r < R0) { src = P.in[3] + (size_t)r * 512; dst = (bf16_t*)(ws + WS_KB) + ((size_t)MP + (size_t)(r >> 10) * SKV + (r & 1023)) * 512; }
            else if (r < 2 * R0) { r -= R0; src = P.in[4] + (size_t)r * 512; dst = (bf16_t*)(ws + WS_VB) + ((size_t)MP + (size_t)(r >> 10) * SKV + (r & 1023)) * 512; }
            else if (r < 2 * R0 + R1) { r -= 2 * R0; src = P.in[5] + (size_t)r * 512; dst = (bf16_t*)(ws + WS_KM) + (size_t)(NBP * NMEM + r) * 512; }
            else { r -= 2 * R0 + R1; src = P.in[6] + (size_t)r * 512; dst = (bf16_t*)(ws + WS_VM) + (size_t)(NBP * NMEM + r) * 512; }
            const f32x4 a = ((const f32x4*)src)[2 * lane], b = ((const f32x4*)src)[2 * lane + 1];
            u32x4 o; o.x = pk2(a[0], a[1]); o.y = pk2(a[2], a[3]); o.z = pk2(b[0], b[1]); o.w = pk2(b[2], b[3]);
            *(u32x4*)(dst + 8 * lane) = o;
        }
    }
    {
        float* rope = (float*)(ws + WS_ROPE);
        for (int e = blockIdx.x * 512 + tid; e < TP * 8; e += gridDim.x * 512) {
            const int pos = e >> 3, i = e & 7;
            const double inv = i == 0 ? 1.0 : i == 1 ? 0.19392274474868576 : i == 2 ? 0.03760603093086393 : i == 3 ? 0.007292664737217109 : i == 4 ? 0.001414213562373095 : i == 5 ? 0.0002742481756762073 : i == 6 ? 5.318295896944988e-05 : 1.031338537721246e-05;
            const double rev = (double)pos * inv * 0.15915494309189535;
            const float fr = (float)(rev - __builtin_rint(rev));
            rope[(size_t)pos * 16 + i] = __builtin_amdgcn_cosf(fr);
            rope[(size_t)pos * 16 + 8 + i] = __builtin_amdgcn_sinf(fr);
        }
    }
}
constexpr int G_K = 0, G_Q = 17408, G_X = 34816, G_KD = 71680, G_M = 92160, G_TB = 109568, G_GC = 118784, G_BE = 119040, G_AT = 119296, G_M21 = 121856, G_CW = 124416;
constexpr int G_XSTR = 576, G_KDSTR = 320;
__device__ __forceinline__ void chunk_unit(const Params& P, LAS unsigned char* lds, int U, int& cw_hd) {
    const int tid = threadIdx.x, lane = tid & 63, wave = __builtin_amdgcn_readfirstlane(tid >> 6), r = lane & 31, h = lane >> 5;
    unsigned char* ws = P.ws;
    const bool smp = U >= NCHUNK_P * 4; const int hd = U & 3, sc = U >> 2;
    const int sq = smp ? (sc - NCHUNK_P) : (sc >> 7), n = smp ? 0 : (sc & 127);
    const int seqbase = smp ? MP + sq * TS : sq * TP;
    const int nvalid = smp ? TS : 64;
    LAS bf16_t* sK = (LAS bf16_t*)(lds + G_K); LAS bf16_t* sQ = (LAS bf16_t*)(lds + G_Q);
    LAS unsigned char* sX = lds + G_X; LAS unsigned char* sKD = lds + G_KD;
    LAS float* sM = (LAS float*)(lds + G_M); LAS bf16_t* sTb = (LAS bf16_t*)(lds + G_TB);
    LAS float* sGC = (LAS float*)(lds + G_GC); LAS float* sBE = (LAS float*)(lds + G_BE);
    LAS bf16_t* sAt = (LAS bf16_t*)(lds + G_AT); LAS bf16_t* sM21 = (LAS bf16_t*)(lds + G_M21);
    LAS float* sCW = (LAS float*)(lds + G_CW);
    unsigned char* chb = ws + WS_CH + (size_t)U * CH_BYTES;
    bf16_t* gNW = (bf16_t*)chb; bf16_t* gQG = (bf16_t*)(chb + 16384); bf16_t* gKDT = (bf16_t*)(chb + 32768); bf16_t* gUT = (bf16_t*)(chb + 49152); bf16_t* gAQK = (bf16_t*)(chb + 65536);
    const int ci = tid >> 3, ccg = tid & 7, ctis = n * 64 + ci;
    u32x4 raw[2][4][2];
#define CH_LOADPART(part_, slot_) do { const bf16_t* qkvpre_ = (const bf16_t*)(ws + WS_QKVPRE); _Pragma("unroll") for (int j_ = 0; j_ < 4; ++j_) { const int tt_ = ctis - 3 + j_; \
        if (ci < nvalid && tt_ >= 0) { const u32x4* sp_ = (const u32x4*)(qkvpre_ + (size_t)(seqbase + tt_) * 1536 + (part_) * 512 + hd * 128 + 16 * ccg); raw[slot_][j_][0] = sp_[0]; raw[slot_][j_][1] = sp_[1]; } \
        else { raw[slot_][j_][0] = (u32x4){0u, 0u, 0u, 0u}; raw[slot_][j_][1] = (u32x4){0u, 0u, 0u, 0u}; } } } while (0)
    CH_LOADPART(0, 0); CH_LOADPART(1, 1);
    if (wave == 0) {
        const int i = lane; float g = 0.f, be = 0.f;
        if (i < nvalid) { const size_t row = (size_t)(seqbase + n * 64 + i); g = ((const float*)(ws + WS_GG))[row * 4 + hd]; be = ((const float*)(ws + WS_GB))[row * 4 + hd]; }
        sGC[i] = g; sBE[i] = be;
        { float acc = 0.f;
#pragma unroll 8
          for (int j = 0; j < 64; ++j) { const float gj = sGC[j]; acc += (j <= i) ? gj : 0.f; }
          g = acc; }
        sGC[i] = g;
        if (lane == 63) ((float*)(ws + WS_GL))[U] = __expf(g);
    }
    if (cw_hd != hd) {
        const float* cw = P.in[11];
        for (int e = tid; e < 4 * 384; e += 512) { const int j = e / 384, c = e % 384; sCW[e] = cw[(size_t)j * 1536 + (c >> 7) * 512 + hd * 128 + (c & 127)]; }
        cw_hd = hd;
    }
    __syncthreads();
    {
        const int i = tid >> 3, cg = tid & 7;
        const float gci = sGC[i], bei = sBE[i], gcl = sGC[63];
        const float eg = __expf(gci), ed = __expf(gcl - gci);
        const bool valid = i < nvalid;
        const int tis = n * 64 + i;
#pragma unroll
        for (int part = 0; part < 3; ++part) {
            const int col0 = part * 512 + hd * 128 + 16 * cg;
            float y[16];
#pragma unroll
            for (int e = 0; e < 16; ++e) y[e] = 0.f;
            if (valid) {
#pragma unroll
                for (int j = 0; j < 4; ++j) {
                    const int tt = tis - 3 + j;
                    float xv[16];
                    if (tt >= 0) {
                        const u32x4 a = raw[part & 1][j][0], b = raw[part & 1][j][1];
                        xv[0] = bf_lo(a.x); xv[1] = bf_hi(a.x); xv[2] = bf_lo(a.y); xv[3] = bf_hi(a.y); xv[4] = bf_lo(a.z); xv[5] = bf_hi(a.z); xv[6] = bf_lo(a.w); xv[7] = bf_hi(a.w);
                        xv[8] = bf_lo(b.x); xv[9] = bf_hi(b.x); xv[10] = bf_lo(b.y); xv[11] = bf_hi(b.y); xv[12] = bf_lo(b.z); xv[13] = bf_hi(b.z); xv[14] = bf_lo(b.w); xv[15] = bf_hi(b.w);
                    } else if (smp) {
                        const f32x4* sp = (const f32x4*)(P.in[8] + (size_t)(sq * 3 + (tt + 3)) * 1536 + col0);
#pragma unroll
                        for (int q = 0; q < 4; ++q) { const f32x4 a = sp[q]; xv[4 * q] = a[0]; xv[4 * q + 1] = a[1]; xv[4 * q + 2] = a[2]; xv[4 * q + 3] = a[3]; }
                    } else {
#pragma unroll
                        for (int e = 0; e < 16; ++e) xv[e] = 0.f;
                    }
                    const LAS f32x4* wp = (const LAS f32x4*)(sCW + j * 384 + part * 128 + 16 * cg);
#pragma unroll
                    for (int q = 0; q < 4; ++q) { const f32x4 w = wp[q]; y[4 * q] += xv[4 * q] * w[0]; y[4 * q + 1] += xv[4 * q + 1] * w[1]; y[4 * q + 2] += xv[4 * q + 2] * w[2]; y[4 * q + 3] += xv[4 * q + 3] * w[3]; }
                }
#pragma unroll
                for (int e = 0; e < 16; ++e) y[e] = y[e] / (1.0f + __expf(-y[e]));
            }
            if (part == 0) CH_LOADPART(2, 0);
            if (part < 2) {
                float ss = 0.f;
#pragma unroll
                for (int e = 0; e < 16; ++e) ss += y[e] * y[e];
                ss += swz_xor<1>(ss); ss += swz_xor<2>(ss); ss += swz_xor<4>(ss);
                const float sc_ = (1.0f / sqrtf(ss + EPS)) * (part == 0 ? 0.08838834764831843f : 1.0f);
#pragma unroll
                for (int e = 0; e < 16; ++e) y[e] *= sc_;
                u32x4 a, b;
                a.x = pk2(y[0], y[1]); a.y = pk2(y[2], y[3]); a.z = pk2(y[4], y[5]); a.w = pk2(y[6], y[7]);
                b.x = pk2(y[8], y[9]); b.y = pk2(y[10], y[11]); b.z = pk2(y[12], y[13]); b.w = pk2(y[14], y[15]);
                LAS bf16_t* dst = (part == 0 ? sQ : sK) + i * 136 + 16 * cg;
                *(LAS u32x4*)dst = a; *(LAS u32x4*)(dst + 8) = b;
                if (part == 0) {
                    u32x4 lo, hi;
                    lo.x = pk2(y[0] * eg, y[1] * eg); lo.y = pk2(y[2] * eg, y[3] * eg); lo.z = pk2(y[8] * eg, y[9] * eg); lo.w = pk2(y[10] * eg, y[11] * eg);
                    hi.x = pk2(y[4] * eg, y[5] * eg); hi.y = pk2(y[6] * eg, y[7] * eg); hi.z = pk2(y[12] * eg, y[13] * eg); hi.w = pk2(y[14] * eg, y[15] * eg);
                    const int fb = ((i >> 5) * 8 + cg) * 64 + (i & 31);
                    *(u32x4*)(gQG + (size_t)fb * 8) = lo; *(u32x4*)(gQG + (size_t)(fb + 32) * 8) = hi;
                } else {
                    const float s1 = bei * eg;
                    u32x4 c, d;
                    c.x = pk2(y[0] * s1, y[1] * s1); c.y = pk2(y[2] * s1, y[3] * s1); c.z = pk2(y[4] * s1, y[5] * s1); c.w = pk2(y[6] * s1, y[7] * s1);
                    d.x = pk2(y[8] * s1, y[9] * s1); d.y = pk2(y[10] * s1, y[11] * s1); d.z = pk2(y[12] * s1, y[13] * s1); d.w = pk2(y[14] * s1, y[15] * s1);
                    *(LAS u32x4*)(sX + i * G_XSTR + 32 * cg) = c; *(LAS u32x4*)(sX + i * G_XSTR + 32 * cg + 16) = d;
                    c.x = pk2(y[0] * ed, y[1] * ed); c.y = pk2(y[2] * ed, y[3] * ed); c.z = pk2(y[4] * ed, y[5] * ed); c.w = pk2(y[6] * ed, y[7] * ed);
                    d.x = pk2(y[8] * ed, y[9] * ed); d.y = pk2(y[10] * ed, y[11] * ed); d.z = pk2(y[12] * ed, y[13] * ed); d.w = pk2(y[14] * ed, y[15] * ed);
                    *(LAS u32x4*)(sKD + i * G_KDSTR + 32 * cg) = c; *(LAS u32x4*)(sKD + i * G_KDSTR + 32 * cg + 16) = d;
                }
            } else {
                u32x4 c, d;
                c.x = pk2(y[0] * bei, y[1] * bei); c.y = pk2(y[2] * bei, y[3] * bei); c.z = pk2(y[4] * bei, y[5] * bei); c.w = pk2(y[6] * bei, y[7] * bei);
                d.x = pk2(y[8] * bei, y[9] * bei); d.y = pk2(y[10] * bei, y[11] * bei); d.z = pk2(y[12] * bei, y[13] * bei); d.w = pk2(y[14] * bei, y[15] * bei);
                *(LAS u32x4*)(sX + i * G_XSTR + 256 + 32 * cg) = c; *(LAS u32x4*)(sX + i * G_XSTR + 256 + 32 * cg + 16) = d;
            }
        }
    }
#undef CH_LOADPART
    __syncthreads();
    const int q4 = (lane & 15) >> 2, p4 = lane & 3, g1 = (lane >> 4) & 1;
    {
        const int prod = wave >> 2, ib = (wave >> 1) & 1, jb = wave & 1;
        f32x16 acc;
#pragma unroll
        for (int e = 0; e < 16; ++e) acc[e] = 0.f;
        if (!(ib == 0 && jb == 1)) {
            const LAS bf16_t* X = prod ? sQ : sK;
#pragma unroll
            for (int ks = 0; ks < 8; ++ks) {
                const bf16x8 a = *(const LAS bf16x8*)(X + (32 * ib + r) * 136 + 16 * ks + 8 * h);
                const bf16x8 b = *(const LAS bf16x8*)(sK + (32 * jb + r) * 136 + 16 * ks + 8 * h);
                acc = MFMA32(a, b, acc);
            }
        }
        const int j = 32 * jb + r; const float gcj = sGC[j];
#pragma unroll
        for (int ii = 0; ii < 16; ++ii) {
            const int i = 32 * ib + crow(ii, h); const float gci = sGC[i];
            const float dec = __expf(fminf(gci - gcj, 0.f));
            if (prod == 0) { const float mv = (i > j) ? sBE[i] * acc[ii] * dec : 0.f; sM[i * 68 + j] = mv; if (ib == 1 && jb == 0) sM21[(i - 32) * 40 + j] = f2bf(mv); }
            else gAQK[fragpos(i, j, 64)] = f2bf((i >= j) ? acc[ii] * dec : 0.f);
        }
    }
#pragma unroll
    for (int ff = 0; ff < 2; ++ff) {
        const int f = wave * 2 + ff, kb = f >> 2, jb = (f >> 1) & 1, s = f & 1;
        const LAS unsigned char* p = sKD + (32 * jb + 16 * s + 4 * h + q4) * G_KDSTR + (32 * kb + 16 * g1) * 2 + 8 * p4;
        const s16x4 lo = vtr(p), hi = vtr(p + 8 * G_KDSTR);
        *(bf16x8*)(gKDT + ((size_t)(f * 64 + lane) << 3)) = __builtin_shufflevector(lo, hi, 0, 1, 2, 3, 4, 5, 6, 7);
    }
    __syncthreads();
    if (wave == 0) {
        int c = r, ic = 0; float T[32];
        asm volatile("" : "+v"(ic));
        const LAS float* mb_ = sM + (32 * h) * 68 + 32 * h;
        { const u32x4 z4 = {0u, 0u, 0u, 0u}; LAS bf16_t* zp = sTb + (lane >> 1) * 72 + 32 + 16 * (lane & 1); *(LAS u32x4*)zp = z4; *(LAS u32x4*)(zp + 8) = z4; }
#pragma unroll
        for (int i = 0; i < 32; ++i) {
            float a0, a1 = 0.f, a2 = 0.f, a3 = 0.f;
            asm volatile("v_cmp_eq_u32 vcc, %1, %2\n\tv_cndmask_b32 %0, 0, 1.0, vcc\n\tv_add_u32 %2, 1, %2" : "=v"(a0), "+v"(c), "+v"(ic) : : "vcc");
#pragma unroll
            for (int j = 0; j + 3 < i; j += 4) { a0 -= mb_[i * 68 + j] * T[j]; a1 -= mb_[i * 68 + j + 1] * T[j + 1]; a2 -= mb_[i * 68 + j + 2] * T[j + 2]; a3 -= mb_[i * 68 + j + 3] * T[j + 3]; }
#pragma unroll
            for (int j = (i & ~3); j < i; ++j) a0 -= mb_[i * 68 + j] * T[j];
            T[i] = (a0 + a1) + (a2 + a3);
            sTb[(32 * h + i) * 72 + 32 * h + c] = f2bf(T[i]);
        }
        if (h == 0) {
            u32x4 w_[4];
#pragma unroll
            for (int q = 0; q < 4; ++q) { w_[q].x = pk2(T[8 * q], T[8 * q + 1]); w_[q].y = pk2(T[8 * q + 2], T[8 * q + 3]); w_[q].z = pk2(T[8 * q + 4], T[8 * q + 5]); w_[q].w = pk2(T[8 * q + 6], T[8 * q + 7]); }
#pragma unroll
            for (int q = 0; q < 4; ++q) *(LAS u32x4*)(sAt + c * 40 + 8 * q) = w_[q];
        }
        f32x16 p1;
#pragma unroll
        for (int e = 0; e < 16; ++e) p1[e] = 0.f;
#pragma unroll
        for (int s = 0; s < 2; ++s) {
            const bf16x8 a = *(const LAS bf16x8*)(sM21 + r * 40 + 16 * s + 8 * h);
            const bf16x8 b = *(const LAS bf16x8*)(sAt + r * 40 + 16 * s + 8 * h);
            p1 = MFMA32(a, b, p1);
        }
        f32x16 cc;
#pragma unroll
        for (int e = 0; e < 16; ++e) cc[e] = 0.f;
#pragma unroll
        for (int s = 0; s < 2; ++s) {
            const bf16x8 pb = pack8(p1, 8 * s);
            const LAS bf16_t* ap = sTb + (32 + r) * 72 + 32 + 16 * s + 4 * h;
            const u32x2 alo = *(const LAS u32x2*)ap, ahi = *(const LAS u32x2*)(ap + 8);
            const u32x4 av = {alo.x, alo.y, ahi.x, ahi.y};
            cc = MFMA32(__builtin_bit_cast(bf16x8, av), pb, cc);
        }
#pragma unroll
        for (int ii = 0; ii < 16; ++ii) sTb[(32 + crow(ii, h)) * 72 + r] = f2bf(-cc[ii]);
    }
    __syncthreads();
    {
        const int nb = wave;
        f32x16 d[2];
#pragma unroll
        for (int ib = 0; ib < 2; ++ib)
#pragma unroll
            for (int e = 0; e < 16; ++e) d[ib][e] = 0.f;
#pragma unroll
        for (int s = 0; s < 4; ++s) {
            const LAS unsigned char* p = sX + (16 * s + 8 * h + q4) * G_XSTR + (32 * nb + 16 * g1) * 2 + 8 * p4;
            const s16x4 lo = vtr(p), hi = vtr(p + 4 * G_XSTR);
            const bf16x8 b = __builtin_shufflevector(lo, hi, 0, 1, 2, 3, 4, 5, 6, 7);
#pragma unroll
            for (int ib = 0; ib < 2; ++ib) {
                const bf16x8 a = *(const LAS bf16x8*)(sTb + (32 * ib + r) * 72 + 16 * s + 8 * h);
                d[ib] = MFMA32(a, b, d[ib]);
            }
        }
        if (nb < 4) {
#pragma unroll
            for (int ib = 0; ib < 2; ++ib)
#pragma unroll
                for (int ii = 0; ii < 16; ++ii) gNW[fragpos(32 * ib + crow(ii, h), 32 * nb + r, 128)] = f2bf(-d[ib][ii]);
        } else {
            const int dvb = nb - 4;
#pragma unroll
            for (int ib = 0; ib < 2; ++ib)
#pragma unroll
                for (int g4 = 0; g4 < 4; ++g4) { u32x2 o; o.x = pk2(d[ib][4 * g4], d[ib][4 * g4 + 1]); o.y = pk2(d[ib][4 * g4 + 2], d[ib][4 * g4 + 3]);
                    *(u32x2*)(gUT + ((size_t)(((dvb * 2 + ib) * 4 + g4) * 64 + lane)) * 4) = o; }
        }
    }
    __syncthreads();
}

__device__ __forceinline__ bf16x8 ldfrag(const bf16_t* img, int frag, int lane) { const char* b = (const char*)img + frag * 1024; return *(const bf16x8*)(b + (unsigned)(lane * 16)); }
#define SCHED_FENCE() __builtin_amdgcn_sched_barrier(0)
constexpr int SC_RING = 57344, SC_OB = 2 * SC_RING, SC_OBSZ = 64 * 128 * 2;
static_assert(SC_OB + 2 * SC_OBSZ <= LDS_BYTES, "scan LDS map");
__device__ __forceinline__ bf16x8 ldsfrag(const LAS unsigned char* img, int frag, int lane) { return *(const LAS bf16x8*)(img + frag * 1024 + lane * 16); }
__device__ __forceinline__ void scan_step(const LAS unsigned char* ring, float gl, f32x16 (&S)[4], const u32x2 (&uu)[8], LAS bf16_t* ob, int wave, int lane, int r, int h) {
    const LAS unsigned char* lNW = ring; const LAS unsigned char* lQG = ring + 16384; const LAS unsigned char* lKDT = ring + 32768; const LAS unsigned char* lAQK = ring + 49152;
    bf16x8 sb[4][2];
#pragma unroll
    for (int kb = 0; kb < 4; ++kb) { sb[kb][0] = pack8(S[kb], 0); sb[kb][1] = pack8(S[kb], 8); }
    f32x16 VN[2];
#pragma unroll
    for (int ib = 0; ib < 2; ++ib)
#pragma unroll
        for (int g4 = 0; g4 < 4; ++g4) { const u32x2 u2 = uu[ib * 4 + g4];
            VN[ib][4 * g4] = bf_lo(u2.x); VN[ib][4 * g4 + 1] = bf_hi(u2.x); VN[ib][4 * g4 + 2] = bf_lo(u2.y); VN[ib][4 * g4 + 3] = bf_hi(u2.y); }
#pragma unroll
    for (int kb = 0; kb < 4; ++kb)
#pragma unroll
        for (int s = 0; s < 2; ++s)
#pragma unroll
            for (int ib = 0; ib < 2; ++ib) VN[ib] = MFMA32(ldsfrag(lNW, ib * 8 + kb * 2 + s, lane), sb[kb][s], VN[ib]);
    f32x16 Oa[2];
#pragma unroll
    for (int ib = 0; ib < 2; ++ib)
#pragma unroll
        for (int ii = 0; ii < 16; ++ii) Oa[ib][ii] = 0.f;
#pragma unroll
    for (int kb = 0; kb < 4; ++kb)
#pragma unroll
        for (int s = 0; s < 2; ++s)
#pragma unroll
            for (int ib = 0; ib < 2; ++ib) Oa[ib] = MFMA32(ldsfrag(lQG, ib * 8 + kb * 2 + s, lane), sb[kb][s], Oa[ib]);
    SCHED_FENCE();
    bf16x8 vnb[2][2];
#pragma unroll
    for (int jb = 0; jb < 2; ++jb) { vnb[jb][0] = pack8(VN[jb], 0); vnb[jb][1] = pack8(VN[jb], 8); }
#pragma unroll
    for (int jb = 0; jb < 2; ++jb)
#pragma unroll
        for (int s = 0; s < 2; ++s)
#pragma unroll
            for (int ib = 0; ib < 2; ++ib) Oa[ib] = MFMA32(ldsfrag(lAQK, ib * 4 + jb * 2 + s, lane), vnb[jb][s], Oa[ib]);
#pragma unroll
    for (int kb = 0; kb < 4; ++kb) S[kb] = S[kb] * gl;
#pragma unroll
    for (int jb = 0; jb < 2; ++jb)
#pragma unroll
        for (int s = 0; s < 2; ++s)
#pragma unroll
            for (int kb = 0; kb < 4; ++kb) S[kb] = MFMA32(ldsfrag(lKDT, kb * 4 + jb * 2 + s, lane), vnb[jb][s], S[kb]);
    SCHED_FENCE();
#pragma unroll
    for (int ib = 0; ib < 2; ++ib)
#pragma unroll
        for (int ii = 0; ii < 16; ++ii) ob[(32 * ib + crow(ii, h)) * 128 + 32 * wave + r] = f2bf(Oa[ib][ii]);
}
__device__ __forceinline__ void scan_unit(const Params& P, LAS unsigned char* lds, int su) {
    const int tid = threadIdx.x, lane = tid & 63, wave = __builtin_amdgcn_readfirstlane(tid >> 6), r = lane & 31, h = lane >> 5;
    unsigned char* ws = P.ws;
    const bool smp = su >= 32; const int hd = su & 3; const int sq = smp ? ((su - 32) >> 2) : (su >> 2);
    const int nsteps = smp ? 1 : 128;
    const int unit0 = smp ? NCHUNK_P * 4 + sq * 4 + hd : (sq * 128) * 4 + hd;
    const int tok0 = smp ? MP + sq * TS : sq * TP; const int nvalid = smp ? TS : 64;
    const float* GL = (const float*)(ws + WS_GL);
    const unsigned char* ch0 = ws + WS_CH + (size_t)unit0 * CH_BYTES;
    __syncthreads();
    if (wave < 4) {
        f32x16 S[4];
#pragma unroll
        for (int kb = 0; kb < 4; ++kb)
#pragma unroll
            for (int ii = 0; ii < 16; ++ii) S[kb][ii] = 0.f;
        if (smp) {
            const float* st = P.in[7] + (size_t)(sq * 4 + hd) * 16384;
#pragma unroll
            for (int kb = 0; kb < 4; ++kb)
#pragma unroll
                for (int ii = 0; ii < 16; ++ii) S[kb][ii] = st[(size_t)(32 * kb + crow(ii, h)) * 128 + 32 * wave + r];
        }
        u32x2 uu[8], un[8];
#pragma unroll
        for (int i = 0; i < 8; ++i) uu[i] = *(const u32x2*)(ch0 + 49152 + (wave * 8 + i) * 512 + (unsigned)(lane * 8));
        __syncthreads();
        for (int n = 0; n < nsteps; ++n) {
            if (n + 1 < nsteps) {
                const unsigned char* chn = ch0 + (size_t)(n + 1) * 4 * CH_BYTES;
#pragma unroll
                for (int i = 0; i < 8; ++i) un[i] = *(const u32x2*)(chn + 49152 + (wave * 8 + i) * 512 + (unsigned)(lane * 8));
            }
            scan_step(lds + (n & 1) * SC_RING, GL[unit0 + n * 4], S, uu, (LAS bf16_t*)(lds + SC_OB + (n & 1) * SC_OBSZ), wave, lane, r, h);
#pragma unroll
            for (int i = 0; i < 8; ++i) uu[i] = un[i];
            __syncthreads();
        }
        float* so = P.out + (smp ? O_SSTATE : O_PSTATE) + (size_t)(sq * 4 + hd) * 16384;
#pragma unroll
        for (int kb = 0; kb < 4; ++kb)
#pragma unroll
            for (int ii = 0; ii < 16; ++ii) so[(size_t)(32 * kb + crow(ii, h)) * 128 + 32 * wave + r] = S[kb][ii];
        __syncthreads();
    } else {
        int t2 = tid - 256; asm volatile("" : "+v"(t2));
        const int ni = t2 >> 2, ncg = t2 & 3, w4 = wave - 4, ln = t2 & 63;
        const float* gnorm = P.in[14];
        f32x4 gq[8];
#pragma unroll
        for (int q = 0; q < 8; ++q) gq[q] = *(const f32x4*)(gnorm + 32 * ncg + 4 * q);
#define SC_DMA(chb_, ringoff_) do { _Pragma("unroll") for (int i_ = 0; i_ < 14; ++i_) { const int o_ = w4 + 4 * i_; const int so_ = o_ < 48 ? o_ * 1024 : 65536 + (o_ - 48) * 1024; \
        __builtin_amdgcn_global_load_lds((const unsigned*)((chb_) + so_ + ln * 16), (LAS unsigned*)(lds + (ringoff_) + o_ * 1024), 16, 0, 0); } } while (0)
        SC_DMA(ch0, 0);
        __syncthreads();
        for (int n = 0; n <= nsteps; ++n) {
            if (n + 1 < nsteps) { const unsigned char* chn = ch0 + (size_t)(n + 1) * 4 * CH_BYTES; SC_DMA(chn, ((n + 1) & 1) * SC_RING); }
            if (n >= 1) {
                const int m = n - 1;
                const LAS bf16_t* ob = (const LAS bf16_t*)(lds + SC_OB + (m & 1) * SC_OBSZ) + ni * 128 + 32 * ncg;
                float o[32]; float ss = 0.f;
#pragma unroll
                for (int q = 0; q < 4; ++q) { const u32x4 v = *(const LAS u32x4*)(ob + 8 * q);
                    o[8 * q] = bf_lo(v.x); o[8 * q + 1] = bf_hi(v.x); o[8 * q + 2] = bf_lo(v.y); o[8 * q + 3] = bf_hi(v.y); o[8 * q + 4] = bf_lo(v.z); o[8 * q + 5] = bf_hi(v.z); o[8 * q + 6] = bf_lo(v.w); o[8 * q + 7] = bf_hi(v.w); }
#pragma unroll
                for (int e = 0; e < 32; ++e) ss += o[e] * o[e];
                ss += swz_xor<1>(ss); ss += swz_xor<2>(ss);
                const float rstd = 1.0f / sqrtf(ss * (1.0f / 128.0f) + EPS);
                if (ni < nvalid) {
                    const size_t row = (size_t)(tok0 + m * 64 + ni);
                    const u32x4* zp = (const u32x4*)((const bf16_t*)(ws + WS_Z) + row * 512 + hd * 128 + 32 * ncg);
                    bf16_t* mp = (bf16_t*)(ws + WS_R1) + row * DM + hd * 128 + 32 * ncg;
#pragma unroll
                    for (int q = 0; q < 4; ++q) {
                        const u32x4 zz = zp[q]; float zv[8];
                        zv[0] = bf_lo(zz.x); zv[1] = bf_hi(zz.x); zv[2] = bf_lo(zz.y); zv[3] = bf_hi(zz.y); zv[4] = bf_lo(zz.z); zv[5] = bf_hi(zz.z); zv[6] = bf_lo(zz.w); zv[7] = bf_hi(zz.w);
                        float ov[8];
#pragma unroll
                        for (int e = 0; e < 8; ++e) { const float z1 = zv[e]; ov[e] = o[8 * q + e] * rstd * gq[2 * q + (e >> 2)][e & 3] * (z1 / (1.0f + __expf(-z1))); }
                        u32x4 a; a.x = pk2(ov[0], ov[1]); a.y = pk2(ov[2], ov[3]); a.z = pk2(ov[4], ov[5]); a.w = pk2(ov[6], ov[7]);
                        *(u32x4*)(mp + 8 * q) = a;
                    }
                }
            }
            __syncthreads();
        }
#undef SC_DMA
    }
}
constexpr int A_KB = 0, A_VB = 3 * 17408, A_VSTR = 320, A_VBUF = 64 * A_VSTR, A_MB = 131072, A_LB = 131072 + 2048;
__device__ __forceinline__ float max3f(float a, float b, float c) { float r; asm("v_max3_f32 %0, %1, %2, %3" : "=v"(r) : "v"(a), "v"(b), "v"(c)); return r; }
template <bool DIFF>
__device__ __forceinline__ void attn_unit(LAS unsigned char* lds, const bf16_t* __restrict__ qrow, const bf16_t* __restrict__ kbase, const bf16_t* __restrict__ vbase,
                                          int NT, int nkeys, bool split, int my_lim, bf16_t* obase, int ldo, float lam, const float* __restrict__ gain) {
    constexpr int NM = DIFF ? 2 : 1, KS = DIFF ? 4 : 8, NG = DIFF ? 4 : 8;
    const int tid = threadIdx.x, lane = tid & 63, wave = __builtin_amdgcn_readfirstlane(tid >> 6), r = lane & 31, h = lane >> 5;
    const int mp = DIFF ? (wave & 1) : 0, grp = DIFF ? (wave >> 1) : wave;
    bf16x8 bq[KS];
#pragma unroll
    for (int f = 0; f < KS; ++f) bq[f] = *(const bf16x8*)(qrow + mp * 64 + f * 16 + h * 8);
    float m_ = -INFINITY; f32x16 O[4], lacc;
    const bf16x8 ones = {0x3F80, 0x3F80, 0x3F80, 0x3F80, 0x3F80, 0x3F80, 0x3F80, 0x3F80};
#pragma unroll
    for (int ii = 0; ii < 16; ++ii) lacc[ii] = 0.f;
#pragma unroll
    for (int db = 0; db < 4; ++db)
#pragma unroll
        for (int ii = 0; ii < 16; ++ii) O[db][ii] = 0.f;
    int goff[5];
#pragma unroll
    for (int i = 0; i < 5; ++i) { int op = wave + 8 * i; op = op > 36 ? 36 : op; const bool isk = op < 17; const int slot = (isk ? op : op - 17) * 64 + lane; const int per = isk ? 17 : 20;
        const int row = slot / per; int pcs = slot - row * per; pcs = pcs > 15 ? 15 : pcs; goff[i] = (row << 10) | (pcs << 4); }
#define A_DMA(t, kb_, vb_) do { _Pragma("unroll") for (int i_ = 0; i_ < 5; ++i_) { int op_ = wave + 8 * i_; op_ = op_ > 36 ? 36 : op_; const bool isk_ = op_ < 17; \
        int key_ = (t) * 64 + (goff[i_] >> 10); key_ = key_ < nkeys ? key_ : nkeys - 1; \
        const char* g_ = (const char*)(isk_ ? kbase : vbase) + (size_t)key_ * 1024 + (goff[i_] & 1023); \
        LAS unsigned char* d_ = lds + (isk_ ? A_KB + (kb_) * 17408 + op_ * 1024 : A_VB + (vb_) * A_VBUF + (op_ - 17) * 1024); \
        __builtin_amdgcn_global_load_lds((const unsigned*)g_, (LAS unsigned*)d_, 16, 0, 0); } } while (0)
#define A_WAITBAR(N) asm volatile("s_waitcnt vmcnt(" #N ") lgkmcnt(0)\n\ts_barrier" ::: "memory")
    __syncthreads();
    asm volatile("s_waitcnt vmcnt(0)" ::: "memory");
    A_DMA(0, 0, 0);
    A_WAITBAR(0);
    const int q4 = (lane & 15) >> 2, p4 = lane & 3, g1 = (lane >> 4) & 1;
    const LAS unsigned char* vb0 = lds + A_VB + (4 * h + q4) * A_VSTR + 32 * g1 + 8 * p4;
#define A_PV(vbuf) do { const LAS unsigned char* vb_l = vb0 + (vbuf) * A_VBUF; \
        _Pragma("unroll") for (int db = 0; db < 4; ++db) _Pragma("unroll") for (int kh = 0; kh < 2; ++kh) _Pragma("unroll") for (int s = 0; s < 2; ++s) { \
            const s16x4 lo = vtr(vb_l + (32 * kh + 16 * s) * A_VSTR + 64 * db); const s16x4 hi = vtr(vb_l + (32 * kh + 16 * s + 8) * A_VSTR + 64 * db); \
            const bf16x8 vf = __builtin_shufflevector(lo, hi, 0, 1, 2, 3, 4, 5, 6, 7); O[db] = MFMA32(vf, pk[kh][s], O[db]); if (db == 0) lacc = MFMA32(ones, pk[kh][s], lacc); } } while (0)
    const bool late = false;
    bool first = true, pact = false;
    bf16x8 pk[2][2];
    int k3 = 0;
    for (int t = 0; t < NT; ++t) {
        const int k3n = (k3 == 2) ? 0 : k3 + 1;
        if (t + 1 < NT) A_DMA(t + 1, k3n, (t + 1) & 3);
        if (late && pact) A_PV((t - 1) & 3);
        const bool active = split ? ((t % NG) == grp) : (t <= my_lim);
        if (active) {
            const LAS unsigned char* kbuf = lds + A_KB + k3 * 17408 + mp * 128;
            const float cin = first ? 0.f : -m_;
            f32x16 s0, s1;
#pragma unroll
            for (int ii = 0; ii < 16; ++ii) { s0[ii] = cin; s1[ii] = cin; }
#pragma unroll
            for (int ks = 0; ks < KS; ++ks) {
                const bf16x8 a0 = *(const LAS bf16x8*)(kbuf + r * 272 + (ks * 16 + h * 8) * 2);
                const bf16x8 a1 = *(const LAS bf16x8*)(kbuf + (32 + r) * 272 + (ks * 16 + h * 8) * 2);
                s0 = MFMA32(a0, bq[ks], s0); s1 = MFMA32(a1, bq[ks], s1);
            }
            if (t * 64 + 64 > nkeys) {
#pragma unroll
                for (int ii = 0; ii < 16; ++ii) { const int key = t * 64 + crow(ii, h); if (key >= nkeys) s0[ii] = -INFINITY; if (key + 32 >= nkeys) s1[ii] = -INFINITY; }
            }
            asm volatile("s_nop 15\n\ts_nop 7" : "+v"(s0), "+v"(s1));
            float mx;
            {
                float a0 = max3f(s0[0], s0[1], s0[2]), a1 = max3f(s0[3], s0[4], s0[5]), a2 = max3f(s0[6], s0[7], s0[8]), a3 = max3f(s0[9], s0[10], s0[11]);
                float b0 = max3f(s1[0], s1[1], s1[2]), b1 = max3f(s1[3], s1[4], s1[5]), b2 = max3f(s1[6], s1[7], s1[8]), b3 = max3f(s1[9], s1[10], s1[11]);
                a0 = max3f(a0, s0[12], s0[13]); a1 = max3f(a1, s0[14], s0[15]); b0 = max3f(b0, s1[12], s1[13]); b1 = max3f(b1, s1[14], s1[15]);
                a0 = max3f(a0, a1, a2); b0 = max3f(b0, b1, b2); mx = max3f(a0, b0, a3); mx = max3f(mx, b3, b3);
            }
            mx = half_max(mx);
            if (first || __any(mx > 6.0f)) {
                const float dl = first ? mx : ((mx > 6.0f) ? mx : 0.f);
                const float alpha = first ? 1.0f : __builtin_amdgcn_exp2f(-dl);
                m_ = first ? mx : m_ + dl; first = false;
                lacc = lacc * alpha;
#pragma unroll
                for (int ii = 0; ii < 16; ++ii) { s0[ii] -= dl; s1[ii] -= dl; }
#pragma unroll
                for (int db = 0; db < 4; ++db) O[db] = O[db] * alpha;
            }
#pragma unroll
            for (int ii = 0; ii < 16; ++ii) { s0[ii] = __builtin_amdgcn_exp2f(s0[ii]); s1[ii] = __builtin_amdgcn_exp2f(s1[ii]); }
            pk[0][0] = pack8(s0, 0); pk[0][1] = pack8(s0, 8); pk[1][0] = pack8(s1, 0); pk[1][1] = pack8(s1, 8);
        }
        if (!late && active) A_PV(t & 3);
        pact = active; k3 = k3n;
        A_WAITBAR(0);
    }
    if (late && pact) A_PV((NT - 1) & 3);
    __syncthreads();
#undef A_PV
#undef A_DMA
#undef A_WAITBAR
    LAS float* red = (LAS float*)lds;
    LAS float* mb = (LAS float*)(lds + A_MB); LAS float* lb = (LAS float*)(lds + A_LB);
    float l_ = lacc[0];
    bool have = true;
    if (split) {
        if (h == 0) mb[wave * 32 + r] = m_;
        __syncthreads();
        float M = mb[mp * 32 + r];
#pragma unroll
        for (int g = 1; g < NG; ++g) M = fmaxf(M, mb[(g * NM + mp) * 32 + r]);
        const float f = __builtin_amdgcn_exp2f(m_ - M);
        l_ *= f;
        if (h == 0) lb[wave * 32 + r] = l_;
#pragma unroll
        for (int db = 0; db < 4; ++db)
#pragma unroll
            for (int ii = 0; ii < 16; ++ii) red[(wave * 64 + db * 16 + ii) * 64 + lane] = O[db][ii] * f;
        __syncthreads();
        have = wave < NM;
        if (have) {
#pragma unroll
            for (int db = 0; db < 4; ++db)
#pragma unroll
                for (int ii = 0; ii < 16; ++ii) { float a = 0.f;
#pragma unroll
                    for (int g = 0; g < NG; ++g) a += red[((g * NM + mp) * 64 + db * 16 + ii) * 64 + lane];
                    O[db][ii] = a; }
            float lt = 0.f;
#pragma unroll
            for (int g = 0; g < NG; ++g) lt += lb[(g * NM + mp) * 32 + r];
            l_ = lt;
        }
        __syncthreads();
    }
    const float linv = 1.0f / l_;
    LAS unsigned char* stg = lds + wave * 8704;
    bool wr = false;
    if (DIFF) {
        if (have && mp == 1) {
#pragma unroll
            for (int db = 0; db < 4; ++db)
#pragma unroll
                for (int ii = 0; ii < 16; ++ii) red[(grp * 64 + db * 16 + ii) * 64 + lane] = O[db][ii] * linv;
        }
        __syncthreads();
        float rstd = 0.f;
        if (have && mp == 0) {
            float ss = 0.f;
#pragma unroll
            for (int db = 0; db < 4; ++db)
#pragma unroll
                for (int ii = 0; ii < 16; ++ii) { const float v = O[db][ii] * linv - lam * red[(grp * 64 + db * 16 + ii) * 64 + lane]; O[db][ii] = v; ss += v * v; }
            ss = half_sum(ss);
            rstd = (1.0f / sqrtf(ss * (1.0f / 128.0f) + EPS)) * 0.8f;
        }
        __syncthreads();
        if (have && mp == 0) {
            wr = true;
#pragma unroll
            for (int db = 0; db < 4; ++db)
#pragma unroll
                for (int g4 = 0; g4 < 4; ++g4) {
                    const int dv = 32 * db + 8 * g4 + 4 * h;
                    const f32x4 g = *(const f32x4*)(gain + dv);
                    u32x2 o; o.x = pk2(O[db][4 * g4] * rstd * g[0], O[db][4 * g4 + 1] * rstd * g[1]); o.y = pk2(O[db][4 * g4 + 2] * rstd * g[2], O[db][4 * g4 + 3] * rstd * g[3]);
                    *(LAS u32x2*)(stg + r * 272 + dv * 2) = o;
                }
        }
    } else {
        if (have) {
            wr = true;
#pragma unroll
            for (int db = 0; db < 4; ++db)
#pragma unroll
                for (int g4 = 0; g4 < 4; ++g4) {
                    const int dv = 32 * db + 8 * g4 + 4 * h;
                    u32x2 o; o.x = pk2(O[db][4 * g4] * linv, O[db][4 * g4 + 1] * linv); o.y = pk2(O[db][4 * g4 + 2] * linv, O[db][4 * g4 + 3] * linv);
                    *(LAS u32x2*)(stg + r * 272 + dv * 2) = o;
                }
        }
    }
    if (wr) {
#pragma unroll
        for (int i = 0; i < 8; ++i) {
            const int row = 4 * i + (lane >> 4), pc16 = lane & 15;
            const u32x4 v = *(const LAS u32x4*)(stg + row * 272 + pc16 * 16);
            *(u32x4*)(obase + (size_t)row * ldo + pc16 * 8) = v;
        }
    }
}
#ifndef MK_REP
#define MK_REP (-1)
#endif
constexpr int N_PHASES = 8;
__device__ __forceinline__ void wait_counter(unsigned* w, unsigned target) {
    __syncthreads();
    if (threadIdx.x == 0) { while (__hip_atomic_load(w, __ATOMIC_RELAXED, __HIP_MEMORY_SCOPE_AGENT) < target) __builtin_amdgcn_s_sleep(4); __builtin_amdgcn_fence(__ATOMIC_ACQUIRE, "agent"); }
    __syncthreads();
}
__device__ __forceinline__ void grid_barrier(unsigned* ctr, unsigned target) {
    asm volatile("s_waitcnt vmcnt(0)" ::: "memory");
    __syncthreads();
    if (threadIdx.x == 0) {
        __builtin_amdgcn_fence(__ATOMIC_RELEASE, "agent");
        const unsigned old = __hip_atomic_fetch_add(ctr, 1u, __ATOMIC_RELAXED, __HIP_MEMORY_SCOPE_AGENT);
        if (old + 1u == target) { __builtin_amdgcn_fence(__ATOMIC_ACQ_REL, "agent"); __hip_atomic_store(ctr + 32, target, __ATOMIC_RELAXED, __HIP_MEMORY_SCOPE_AGENT); }
        else while (__hip_atomic_load(ctr + 32, __ATOMIC_RELAXED, __HIP_MEMORY_SCOPE_AGENT) < target) __builtin_amdgcn_s_sleep(8);
        __builtin_amdgcn_fence(__ATOMIC_ACQUIRE, "agent");
    }
    __syncthreads();
}
constexpr int N_DIFF_P = NBP * 4 * (TP / 128);
constexpr int N_DIFF_UNITS = N_DIFF_P + NBS * 4;
__global__ void __launch_bounds__(512, 2) mk_fwd(Params P) {
    extern __shared__ __attribute__((aligned(16))) unsigned char lds_raw[];
    LAS unsigned char* lds = (LAS unsigned char*)lds_raw;
    const int tid = threadIdx.x, lane = tid & 63, wave = __builtin_amdgcn_readfirstlane(tid >> 6), r = lane & 31;
    unsigned char* ws = P.ws;
    const int lo = P.ph_lo, hi = P.ph_hi, G = gridDim.x;
#ifndef MK_PHMASK
#define MK_PHMASK 0xff
#endif
#define IN(k) (((MK_PHMASK >> (k)) & 1) && lo <= (k) && (k) < hi)
#define SEAM(k) do { if (IN(k) && IN((k) + 1)) { grid_barrier((unsigned*)(ws + WS_BAR), (unsigned)G * (unsigned)(++nbar)); } } while (0)
    int nbar = 0;
#define PH_BEGIN(k) if (IN(k)) {
#define PH_END }
    if (P.ph_hi < 0) cg::this_grid().sync();
    PH_BEGIN(0) p0_prologue(P, lds); PH_END
    SEAM(0);
    PH_BEGIN(1) {
        {
            pg8::Gemm g{(const bf16_t*)(ws + WS_R1), (const bf16_t*)(ws + WS_WIN), MP, NIN, DM, DM}; pg8::StaticOrder S; S.init(MP, NIN, G, (int)blockIdx.x);
            pg8::EpiIn E{(bf16_t*)(ws + WS_QKVPRE), (bf16_t*)(ws + WS_Z), (bf16_t*)(ws + WS_QD), (bf16_t*)(ws + WS_KB), (bf16_t*)(ws + WS_VB), P.out, (const float*)(ws + WS_ROPE)};
            pg8::gemm_phase<pg8::EpiIn, pg8::StaticOrder, true, true>(lds, g, S, E);
        }
    } PH_END
    SEAM(1);
    PH_BEGIN(2) { int cw_hd = -1; for (int U = blockIdx.x; U < NCHUNK_P * 4; U += G) chunk_unit(P, lds, U, cw_hd); } PH_END
    SEAM(2);
    PH_BEGIN(3) {
        if (P.sub & 1) { for (int su = blockIdx.x; su < 96; su += G) { if (su >= 32) wait_counter((unsigned*)(ws + WS_CTR) + 160, 64u); scan_unit(P, lds, su);
            if (su >= 32) { asm volatile("s_waitcnt vmcnt(0)" ::: "memory"); __syncthreads(); if (tid == 0) { __builtin_amdgcn_fence(__ATOMIC_RELEASE, "agent"); __hip_atomic_fetch_add((unsigned*)(ws + WS_CTR) + 128, 1u, __ATOMIC_RELAXED, __HIP_MEMORY_SCOPE_AGENT); } } } }
        if ((P.sub & 2) && G >= 160 && blockIdx.x >= 128 && blockIdx.x < 160) {
            const int tc = (int)blockIdx.x - 128; unsigned* cw = (unsigned*)(ws + WS_CTR);
            int tb = 0;
#define TEAM_WAIT(word, target) do { asm volatile("s_waitcnt vmcnt(0)" ::: "memory"); __syncthreads(); if (threadIdx.x == 0) { __builtin_amdgcn_fence(__ATOMIC_RELEASE, "agent"); \
            while (__hip_atomic_load(cw + (word), __ATOMIC_RELAXED, __HIP_MEMORY_SCOPE_AGENT) < (unsigned)(target)) __builtin_amdgcn_s_sleep(4); \
            __builtin_amdgcn_fence(__ATOMIC_ACQUIRE, "agent"); } __syncthreads(); } while (0)
#define TEAM_BAR() do { asm volatile("s_waitcnt vmcnt(0)" ::: "memory"); __syncthreads(); if (threadIdx.x == 0) { __builtin_amdgcn_fence(__ATOMIC_RELEASE, "agent"); __hip_atomic_fetch_add(cw + 160, 1u, __ATOMIC_RELAXED, __HIP_MEMORY_SCOPE_AGENT); } ++tb; TEAM_WAIT(160, 32 * tb); } while (0)
#define XBv ((bf16_t*)(P.ws + WS_XBS) - (size_t)MP * DM)
#define QMv ((bf16_t*)(P.ws + WS_QMS) - (size_t)MP * 512)
#define Hv ((bf16_t*)(P.ws + WS_HS) - (size_t)MP * DFF)
            {
                pg8::Gemm g{(const bf16_t*)(ws + WS_R1), (const bf16_t*)(ws + WS_WIN), MT, NIN, DM, DM}; pg8::TeamOrder S; S.init(MP / 256, MS / 256, NIN / 256, 32, tc);
                pg8::EpiIn E{(bf16_t*)(ws + WS_QKVPRE), (bf16_t*)(ws + WS_Z), (bf16_t*)(ws + WS_QD), (bf16_t*)(ws + WS_KB), (bf16_t*)(ws + WS_VB), P.out, (const float*)(ws + WS_ROPE)};
                pg8::gemm_phase<pg8::EpiIn, pg8::TeamOrder, true, true>(lds, g, S, E);
            }
            TEAM_BAR();
            { int cw_hd = -1; for (int cu = tc; cu < NBS * 4; cu += 32) chunk_unit(P, lds, NCHUNK_P * 4 + cu, cw_hd); }
            TEAM_BAR();
            TEAM_WAIT(128, 128);
            {
                pg8::Gemm g{(const bf16_t*)(ws + WS_R1), (const bf16_t*)(ws + WS_WOUT), MT, DM, DM, DM}; pg8::TeamOrder S; S.init(MP / 256, MS / 256, DM / 256, 32, tc);
                pg8::EpiRes E{P.in[0], P.in[1], P.out + O_Y, XBv, (float*)(ws + WS_SSQ)};
                pg8::gemm_phase<pg8::EpiRes, pg8::TeamOrder, true, true>(lds, g, S, E);
            }
            TEAM_BAR();
            {
                pg8::Gemm g{XBv, (const bf16_t*)(ws + WS_WMQ), MT, 512, DM, DM}; pg8::TeamOrder S; S.init(MP / 256, MS / 256, 2, 32, tc);
                pg8::EpiScale<0> E{QMv, 512, (const float*)(ws + WS_SSQ), QSCALE_M};
                pg8::gemm_phase<pg8::EpiScale<0>, pg8::TeamOrder, true, true>(lds, g, S, E);
            }
            TEAM_BAR();
            for (int su = tc; su < NBS * 4; su += 32) {
                const int s = su >> 2, hd = su & 3; const size_t row0 = (size_t)MP + s * TS, row = row0 + r;
                attn_unit<false>(lds, QMv + row * 512 + hd * 128, (const bf16_t*)(ws + WS_KM) + (size_t)(NBP * NMEM + s * NMEM) * 512 + hd * 128, (const bf16_t*)(ws + WS_VM) + (size_t)(NBP * NMEM + s * NMEM) * 512 + hd * 128,
                                 4, NMEM, true, 0, QMv + row0 * 512 + hd * 128, 512, 0.f, nullptr);
            }
            TEAM_BAR();
            {
                pg8::Gemm g{QMv, (const bf16_t*)(ws + WS_WMO), MT, DM, 512, 512}; pg8::TeamOrder S; S.init(MP / 256, MS / 256, DM / 256, 32, tc);
                pg8::EpiRes E{P.out + O_Y, P.out + O_Y + (size_t)MP * DM, P.out + O_Y, XBv, (float*)(ws + WS_SSQ)};
                pg8::gemm_phase<pg8::EpiRes, pg8::TeamOrder, true, true>(lds, g, S, E);
            }
            TEAM_BAR();
            {
                pg8::Gemm g{XBv, (const bf16_t*)(ws + WS_WUP), MT, DFF, DM, DM}; pg8::TeamOrder S; S.init(MP / 256, MS / 256, DFF / 256, 32, tc);
                pg8::EpiScale<1> E{Hv, DFF, (const float*)(ws + WS_SSQ), 1.0f};
                pg8::gemm_phase<pg8::EpiScale<1>, pg8::TeamOrder, true, true>(lds, g, S, E);
            }
            TEAM_BAR();
            {
                pg8::Gemm g{Hv, (const bf16_t*)(ws + WS_WDN), MT, DM, DFF, DFF}; pg8::TeamOrder S; S.init(MP / 256, MS / 256, DM / 256, 32, tc);
                pg8::EpiRes E{P.out + O_Y, P.out + O_Y + (size_t)MP * DM, P.out + O_Y, nullptr, nullptr};
                pg8::gemm_phase<pg8::EpiRes, pg8::TeamOrder, true, true>(lds, g, S, E);
            }
            TEAM_BAR();
            {
                const float* gf = P.in[26];
                for (int m = MP + tc * 8 + wave; m < MT; m += 32 * 8) {
                    f32x4* yp = (f32x4*)(P.out + O_Y + (size_t)m * DM);
                    f32x4 v[4]; float ss = 0.f;
#pragma unroll
                    for (int j = 0; j < 4; ++j) { v[j] = yp[64 * j + lane]; ss += (v[j][0] * v[j][0] + v[j][1] * v[j][1]) + (v[j][2] * v[j][2] + v[j][3] * v[j][3]); }
                    const float rstd = 1.0f / sqrtf(wave_sum(ss) * (1.0f / DM) + EPS);
#pragma unroll
                    for (int j = 0; j < 4; ++j) yp[64 * j + lane] = v[j] * rstd * ((const f32x4*)gf)[64 * j + lane];
                }
            }
            __syncthreads();
#undef TEAM_WAIT
#undef TEAM_BAR
#undef XBv
#undef QMv
#undef Hv
        }
        if ((P.sub & 2) && G >= 192 && blockIdx.x >= 160 && blockIdx.x < 192) {
            const int mu = (int)blockIdx.x - 160;
            pg8::Gemm g{(const bf16_t*)(ws + WS_MH), (const bf16_t*)(ws + WS_WMKV), NBP * NMEM, 1024, DM, DM}; pg8::OneUnit S{mu >> 2, mu & 3};
            pg8::EpiMem E{(bf16_t*)(ws + WS_KM), (bf16_t*)(ws + WS_VM), P.out};
            pg8::gemm_phase<pg8::EpiMem, pg8::OneUnit, false, true>(lds, g, S, E);
            __syncthreads();
        }
        float lam;
        { const float* lf = P.in[15]; const float s1 = wave_sum(lf[lane] * lf[64 + lane]), s2 = wave_sum(lf[128 + lane] * lf[192 + lane]); lam = expf(s1) - expf(s2) + 0.2f; }
        LAS int* qslot = (LAS int*)(lds + LDS_BYTES - 64);
        unsigned* ctr = (unsigned*)(ws + WS_CTR);
        const int x0 = (int)(__builtin_amdgcn_s_getreg((3 << 11) | 20) & 7u);
        int att = 0;
        for (;;) {
            __syncthreads();
            if (tid == 0) {
                int code = -1;
                while (att < 8) { const int x = (x0 + att) & 7; const int j = (int)atomicAdd(ctr + x * 16, 1u); if (j < 264) { code = x * 512 + j; break; } ++att; }
                qslot[0] = code; qslot[1] = att;
            }
            __syncthreads();
            const int code = qslot[0]; att = qslot[1];
            if (code < 0 || !(P.sub & 2)) break;
            const int qx = code >> 9, qj = code & 511;
            const int qp = qj < 8 ? qj : qj - 8;
            const int u = (qj >= 8 && qj < 16) ? N_DIFF_P + 8 * qx + (qj - 8) : ((qp >> 2) << 5) + 4 * qx + (qp & 3);
            const bf16_t *qrow, *kbase, *vbase; bf16_t* orow; int NT, nkeys, my_lim; bool split;
            const int grp = wave >> 1;
            int rr = r; asm volatile("" : "+v"(rr));
            if (u < N_DIFF_P) {
                const int qb = 63 - (u >> 5), b = (u & 31) >> 2, hd = u & 3;
                const size_t row0 = (size_t)b * TP + qb * 128 + 32 * grp, row = row0 + rr;
                qrow = (const bf16_t*)(ws + WS_QD) + row * 512 + hd * 128;
                kbase = (const bf16_t*)(ws + WS_KB) + (size_t)b * TP * 512 + hd * 128; vbase = (const bf16_t*)(ws + WS_VB) + (size_t)b * TP * 512 + hd * 128;
                NT = 2 * qb + 2; nkeys = NT * 64; my_lim = 2 * qb + (grp >> 1); split = false;
                orow = (bf16_t*)(ws + WS_R1) + row0 * DM + 512 + hd * 128;
            } else {
                const int s = (u - N_DIFF_P) >> 2, hd = u & 3;
                const size_t row0 = (size_t)MP + s * TS, row = row0 + rr;
                qrow = (const bf16_t*)(ws + WS_QD) + row * 512 + hd * 128;
                kbase = (const bf16_t*)(ws + WS_KB) + ((size_t)MP + (size_t)s * SKV) * 512 + hd * 128; vbase = (const bf16_t*)(ws + WS_VB) + ((size_t)MP + (size_t)s * SKV) * 512 + hd * 128;
                NT = (SKV + 63) / 64; nkeys = SKV; my_lim = 0; split = true;
                orow = (bf16_t*)(ws + WS_R1) + row0 * DM + 512 + hd * 128;
            }
#ifndef MK_NODIFF
            if (u >= N_DIFF_P) wait_counter(ctr + 160, 32u);
            attn_unit<true>(lds, qrow, kbase, vbase, NT, nkeys, split, my_lim, orow, DM, lam, P.in[16]);
#endif
            if (u >= N_DIFF_P) { asm volatile("s_waitcnt vmcnt(0)" ::: "memory"); __syncthreads(); if (tid == 0) { __builtin_amdgcn_fence(__ATOMIC_RELEASE, "agent"); __hip_atomic_fetch_add(ctr + 128, 1u, __ATOMIC_RELAXED, __HIP_MEMORY_SCOPE_AGENT); } }
        }
    } PH_END
    SEAM(3);
    PH_BEGIN(4) {
#define WG_SEAM() do { asm volatile("s_waitcnt vmcnt(0)" ::: "memory"); __syncthreads(); if (threadIdx.x == 0) __builtin_amdgcn_fence(__ATOMIC_ACQUIRE, "agent"); __syncthreads(); } while (0)
        if (blockIdx.x < MP / 256) {
            const int pm0_ = blockIdx.x;
#define PM_OPAQUE() int pm = pm0_; asm volatile("" : "+s"(pm));
            {
                PM_OPAQUE()
                pg8::Gemm g{(const bf16_t*)(ws + WS_R1), (const bf16_t*)(ws + WS_WOUT), MP, DM, DM, DM}; pg8::RowOrder S{pm, DM / 256};
                pg8::EpiRes E{P.in[0], P.in[1], P.out + O_Y, (bf16_t*)(ws + WS_R2), (float*)(ws + WS_SSQ)};
                pg8::gemm_phase<pg8::EpiRes, pg8::RowOrder, true, true>(lds, g, S, E);
            }
            WG_SEAM();
            {
                PM_OPAQUE()
                pg8::Gemm g{(const bf16_t*)(ws + WS_R2), (const bf16_t*)(ws + WS_WMQ), MP, 512, DM, DM}; pg8::RowOrder S{pm, 2};
                pg8::EpiScale<0> E{(bf16_t*)(ws + WS_QM), 512, (const float*)(ws + WS_SSQ), QSCALE_M};
                pg8::gemm_phase<pg8::EpiScale<0>, pg8::RowOrder, true, true>(lds, g, S, E);
            }
            WG_SEAM();
            for (int hd = 0; hd < 4; ++hd) {
                PM_OPAQUE()
                const int seq = pm >> 5; const size_t row0 = (size_t)pm * 256 + 32 * wave, row = row0 + r;
                bf16_t* qp = (bf16_t*)(ws + WS_QM);
                attn_unit<false>(lds, qp + row * 512 + hd * 128, (const bf16_t*)(ws + WS_KM) + (size_t)seq * NMEM * 512 + hd * 128, (const bf16_t*)(ws + WS_VM) + (size_t)seq * NMEM * 512 + hd * 128,
                                 4, NMEM, false, 3, qp + row0 * 512 + hd * 128, 512, 0.f, nullptr);
            }
            WG_SEAM();
            {
                PM_OPAQUE()
                pg8::Gemm g{(const bf16_t*)(ws + WS_QM), (const bf16_t*)(ws + WS_WMO), MP, DM, 512, 512}; pg8::RowOrder S{pm, DM / 256};
                pg8::EpiRes E{P.out + O_Y, P.out + O_Y + (size_t)MP * DM, P.out + O_Y, (bf16_t*)(ws + WS_R2), (float*)(ws + WS_SSQ)};
                pg8::gemm_phase<pg8::EpiRes, pg8::RowOrder, true, true>(lds, g, S, E);
            }
            WG_SEAM();
        }
#undef PM_OPAQUE
#undef WG_SEAM
    } PH_END
    SEAM(4);
    PH_BEGIN(5) {
        pg8::Gemm g{(const bf16_t*)(ws + WS_R2), (const bf16_t*)(ws + WS_WUP), MP, DFF, DM, DM}; pg8::StaticOrder S; S.init(MP, DFF, G, (int)blockIdx.x);
        pg8::EpiScale<1> E{(bf16_t*)(ws + WS_H), DFF, (const float*)(ws + WS_SSQ), 1.0f};
        pg8::gemm_phase<pg8::EpiScale<1>, pg8::StaticOrder, true, true>(lds, g, S, E);
    } PH_END
    SEAM(5);
    PH_BEGIN(6) {
        pg8::Gemm g{(const bf16_t*)(ws + WS_H), (const bf16_t*)(ws + WS_WDN), MP, DM, DFF, DFF}; pg8::StaticOrder S; S.init(MP, DM, G, (int)blockIdx.x);
        pg8::EpiRes E{P.out + O_Y, P.out + O_Y + (size_t)MP * DM, P.out + O_Y, nullptr, nullptr};
        pg8::gemm_phase<pg8::EpiRes, pg8::StaticOrder, true, true>(lds, g, S, E);
    } PH_END
    SEAM(6);
    PH_BEGIN(7) {
        const float* gf = P.in[26];
        f32x4 gn[4];
#pragma unroll
        for (int j = 0; j < 4; ++j) gn[j] = ((const f32x4*)gf)[64 * j + lane];
        for (int m = blockIdx.x * 8 + wave; m < MP; m += G * 8) {
            f32x4* yp = (f32x4*)(P.out + O_Y + (size_t)m * DM);
            f32x4 v[4]; float ss = 0.f;
#pragma unroll
            for (int j = 0; j < 4; ++j) { v[j] = yp[64 * j + lane]; ss += (v[j][0] * v[j][0] + v[j][1] * v[j][1]) + (v[j][2] * v[j][2] + v[j][3] * v[j][3]); }
            const float rstd = 1.0f / sqrtf(wave_sum(ss) * (1.0f / DM) + EPS);
#pragma unroll
            for (int j = 0; j < 4; ++j) yp[64 * j + lane] = v[j] * rstd * gn[j];
        }
    } PH_END
#undef IN
#undef SEAM
}

extern "C" void kernel_launch(void* const* d_in, const int* in_sizes, int n_in, void* d_out, int out_size, void* d_ws, size_t ws_size, hipStream_t stream) {
    static int grid = 0;
    if (grid == 0) {
        if (n_in != 27 || (size_t)out_size != O_END || ws_size < WS_END || ws_size < WS_H + (size_t)MT * DFF * 2) {
            fprintf(stderr, "kernel_launch: unexpected shapes (n_in %d out %d ws %zu)\n", n_in, out_size, ws_size); grid = -1; return; }
        int dev = 0, cus = 0, per_cu = 0;
        hipGetDevice(&dev); hipDeviceGetAttribute(&cus, hipDeviceAttributeMultiprocessorCount, dev);
        hipFuncSetAttribute((const void*)mk_fwd, hipFuncAttributeMaxDynamicSharedMemorySize, LDS_BYTES);
        if (hipOccupancyMaxActiveBlocksPerMultiprocessor(&per_cu, (const void*)mk_fwd, 512, LDS_BYTES) != hipSuccess || per_cu < 1) per_cu = 1;
        (void)hipGetLastError();
        grid = cus * 1;
        if (grid < 256) { fprintf(stderr, "kernel_launch: this kernel needs 256 co-resident workgroups (one per CU), device has %d CUs\n", cus); grid = -1; return; }
    }
    if (grid < 0) return;
    (void)hipMemsetAsync((unsigned char*)d_ws + WS_BAR, 0, 256, stream);
    Params p{};
    for (int i = 0; i < 27; ++i) p.in[i] = (const float*)d_in[i];
    p.out = (float*)d_out; p.ws = (unsigned char*)d_ws; p.sub = 3;
#if MK_SINGLE
    p.ph_lo = 0; p.ph_hi = N_PHASES;
    void* args[] = {&p};
    hipError_t e = hipLaunchCooperativeKernel((const void*)mk_fwd, dim3(grid), dim3(512), args, LDS_BYTES, stream);
    if (e != hipSuccess) fprintf(stderr, "cooperative launch failed: %s (grid %d)\n", hipGetErrorString(e), grid);
#else
    for (int k = 0; k < N_PHASES; ++k) {
        p.ph_lo = k; p.ph_hi = k + 1;
#if defined(MK_SUBREP)
        if (k == 3) {
            for (int sb = 1; sb <= 2; ++sb) for (int rep = 0; rep < (sb == MK_SUBREP ? 2 : 1); ++rep) {
                (void)hipMemsetAsync((unsigned char*)d_ws + WS_CTR, 0, 512, stream);
                p.sub = sb; hipLaunchKernelGGL(mk_fwd, dim3(grid), dim3(512), LDS_BYTES, stream, p); }
            p.sub = 3; continue;
        }
#endif
        for (int rep = 0; rep < (k == MK_REP ? 2 : 1); ++rep) {
            if (rep) (void)hipMemsetAsync((unsigned char*)d_ws + WS_CTR, 0, 512, stream);
            hipLaunchKernelGGL(mk_fwd, dim3(grid), dim3(512), LDS_BYTES, stream, p);
        }
    }
#endif
}
```
